# Optimizing an MI355X kernel written in HIP

```python
import math
import jax, jax.numpy as jnp
from jax import lax
import numpy as np

D_MODEL = 2048
BATCH = 16
SEQ = 256
DEPTH = 2
DEC_BATCH = 8
DEC_SEQ = 4096
PAST_LEN = 256

GRID_W = 64
N_MOD = 9
FFN_DIM = ((8 * D_MODEL // 3 + 127) // 128) * 128
HY_W = D_MODEL // 2
HY_SHORT = 3
HY_BANDS = 8
HY_EMB = 1 + 2 * HY_BANDS
HY_FILTER_HIDDEN = 64
HY_FILTER_GAIN = 0.1
HY_DECAY_SLOW = abs(math.log(1e-2)) / 1.5
HY_DECAY_FAST = abs(math.log(1e-2)) / 0.3
GLA_HEADS = 4
GLA_DK = D_MODEL // 16
GLA_DV = D_MODEL // 8
GLA_W = GLA_HEADS * GLA_DV
GLA_RANK = 16
GLA_TAU = 16.0
GLA_CHUNK = 64
DIFF_HEADS = 8
DIFF_DH = D_MODEL // 32
DIFF_DV = 2 * DIFF_DH
DIFF_W = DIFF_HEADS * DIFF_DV
ROPE_THETA = 10000.0
Q_BLOCK = 128
N_BRANCH = 3
LN_EPS = 1e-5
RMS_EPS = 1e-6
ALPHA = (2 * DEPTH) ** 0.25
BETA = (8 * DEPTH) ** -0.25
IN_SPLITS = (3 * HY_W, GLA_HEADS * GLA_DK, GLA_HEADS * GLA_DK, GLA_W, GLA_W, 2 * GLA_RANK,
             DIFF_HEADS * 2 * DIFF_DH, DIFF_HEADS * 2 * DIFF_DH, DIFF_W, N_BRANCH * D_MODEL)
IN_COLS = sum(IN_SPLITS)

kernel_name = 'hybrid_diffusion_prefix_backbone_step'


def _layer_norm(x, g, b):
    xf = x.astype(jnp.float32)
    mu = xf.mean(-1, keepdims=True)
    var = jnp.square(xf - mu).mean(-1, keepdims=True)
    return ((xf - mu) * lax.rsqrt(var + LN_EPS) * g + b).astype(x.dtype)


def _rms_norm(x, g):
    xf = x.astype(jnp.float32)
    return (xf * lax.rsqrt(jnp.mean(xf * xf, -1, keepdims=True) + RMS_EPS) * g).astype(x.dtype)


def _swiglu(h, w1, w3, w2):
    return (jax.nn.silu(h @ w1) * (h @ w3)) @ w2


def _short_conv(u, w, b):
    up = jnp.pad(u, ((0, 0), (1, 1), (0, 0)))
    return up[:, :-2] * w[0] + up[:, 1:-1] * w[1] + up[:, 2:] * w[2] + b


def _hyena_filters(L, P):
    t = jnp.linspace(0.0, 1.0, L, dtype=jnp.float32)
    w = (2.0 * math.pi / L) * jnp.arange(L, dtype=jnp.float32)
    f = jnp.linspace(1e-4, HY_BANDS - 1, HY_BANDS, dtype=jnp.float32)
    feats = jnp.concatenate([t[:, None], jnp.cos(w[:, None] * f), -jnp.sin(w[:, None] * f)], -1)
    hdn = jnp.sin(P['hy_freq'][0] * (feats @ P['hy_w1'] + P['hy_b1']))
    hdn = jnp.sin(P['hy_freq'][1] * (hdn @ P['hy_w2'] + P['hy_b2']))
    h = (hdn @ P['hy_w3']) * jnp.exp(-t[:, None] * jnp.abs(P['hy_decay']))
    h = h.astype(jnp.float32).reshape(L, 2, 2, HY_W)
    fwd, bwd = h[:, :, 0], h[:, :, 1]
    two_sided = jnp.concatenate([fwd, jnp.zeros((1, 2, HY_W), jnp.float32), bwd[:0:-1]], axis=0)
    return jnp.fft.rfft(two_sided, axis=0)


def _long_conv(z, kf, bias):
    L = z.shape[1]
    zf32 = z.astype(jnp.float32)
    y = jnp.fft.irfft(jnp.fft.rfft(zf32, n=2 * L, axis=1) * kf, n=2 * L, axis=1)[:, :L]
    return (y + zf32 * bias).astype(z.dtype)


def _hyena(u, P):
    L = u.shape[1]
    u = _short_conv(u, P['hy_conv_w'], P['hy_conv_b'])
    v, x1, x2 = jnp.split(u, 3, axis=-1)
    kf = _hyena_filters(L, P)
    z = x1 * _long_conv(v, kf[:, 0], P['hy_bias'][0])
    return x2 * _long_conv(z, kf[:, 1], P['hy_bias'][1])


def _gla_chunked(q, k, v, log_a, s0):
    B_, L, H, _ = q.shape
    dv = v.shape[-1]
    n = L // GLA_CHUNK

    def chunks(a):
        return a.astype(jnp.float32).reshape(B_, n, GLA_CHUNK, H, a.shape[-1])

    q, k, v, log_a = chunks(q), chunks(k), chunks(v), chunks(log_a)
    b = jnp.cumsum(log_a, axis=2)
    ref = b[:, :, GLA_CHUNK // 2 - 1:GLA_CHUNK // 2]
    att = jnp.einsum('bnthk,bnshk->bnhts', q * jnp.exp(b - ref), k * jnp.exp(ref - b))
    lower = jnp.tril(jnp.ones((GLA_CHUNK, GLA_CHUNK), dtype=bool))
    att = jnp.where(lower, att, 0.0)
    o_intra = jnp.einsum('bnhts,bnshv->bnthv', att, v)
    b_last = b[:, :, -1:]
    q_in = q * jnp.exp(b)
    k_st = k * jnp.exp(b_last - b)
    decay = jnp.exp(b_last[:, :, 0])

    def step(S, xs):
        qn, kn, vn, dn = xs
        o = jnp.einsum('bthk,bhkv->bthv', qn, S)
        S = dn[..., None] * S + jnp.einsum('bshk,bshv->bhkv', kn, vn)
        return S, o

    xs = (jnp.moveaxis(q_in, 1, 0), jnp.moveaxis(k_st, 1, 0), jnp.moveaxis(v, 1, 0), jnp.moveaxis(decay, 1, 0))
    S, o_inter = lax.scan(step, s0.astype(jnp.float32), xs)
    o = o_intra + jnp.moveaxis(o_inter, 0, 1)
    return o.reshape(B_, L, H, dv), S


def _gla_branch(gq, gk, gv, gr, glr, P, s0f, s0b):
    B_, L, _ = gq.shape
    dt = gq.dtype
    q = gq.reshape(B_, L, GLA_HEADS, GLA_DK) * GLA_DK ** -0.5
    k = gk.reshape(B_, L, GLA_HEADS, GLA_DK)
    v = gv.reshape(B_, L, GLA_HEADS, GLA_DV)
    lr = glr.astype(jnp.float32)

    def log_gate(d):
        logits = lr[..., d * GLA_RANK:(d + 1) * GLA_RANK] @ P['gla_wa'][d].astype(jnp.float32) + P['gla_ba'][d].astype(jnp.float32)
        return (jax.nn.log_sigmoid(logits) / GLA_TAU).reshape(B_, L, GLA_HEADS, GLA_DK)

    def flip(a):
        return jnp.flip(a, axis=1)

    o_f, s_f = _gla_chunked(q, k, v, log_gate(0), s0f)
    o_b, s_b = _gla_chunked(flip(q), flip(k), flip(v), flip(log_gate(1)), s0b)
    o = o_f + flip(o_b)
    o = _rms_norm(o, P['gla_norm_g']) * jax.nn.silu(gr.astype(jnp.float32)).reshape(B_, L, GLA_HEADS, GLA_DV)
    return o.reshape(B_, L, GLA_W).astype(dt), jnp.stack([s_f, s_b], axis=1).astype(dt)


def _axial_rope(L):
    rows = L // GRID_W
    r = jnp.repeat(jnp.arange(rows, dtype=jnp.float32), GRID_W)
    col = jnp.tile(jnp.arange(GRID_W, dtype=jnp.float32), rows)
    nf = DIFF_DH // 4
    inv = ROPE_THETA ** (-jnp.arange(nf, dtype=jnp.float32) / nf)
    ang = jnp.stack([r[:, None] * inv, col[:, None] * inv], axis=1)
    return jnp.cos(ang)[None, :, None, None], jnp.sin(ang)[None, :, None, None]


def _apply_rope(x, cos, sin):
    xs = x.reshape(x.shape[:-1] + (2, 2, DIFF_DH // 4))
    x1, x2 = xs[..., 0, :], xs[..., 1, :]
    cos, sin = cos.astype(x.dtype), sin.astype(x.dtype)
    out = jnp.stack([x1 * cos - x2 * sin, x1 * sin + x2 * cos], axis=-2)
    return out.reshape(x.shape)


def _diff_attend(q, k, v, lam):
    B_, Lq, H, _, dh = q.shape
    nb = Lq // Q_BLOCK
    qb = jnp.swapaxes(q.reshape(B_, nb, Q_BLOCK, H, 2, dh), 0, 1)
    scale = dh ** -0.5

    def block(qi):
        s = jnp.einsum('bqhjd,bkhjd->bhjqk', qi, k).astype(jnp.float32) * scale
        p = jax.nn.softmax(s, axis=-1)
        a = p[:, :, 0] - lam * p[:, :, 1]
        return jnp.einsum('bhqk,bkhv->bqhv', a.astype(v.dtype), v)

    o = lax.map(block, qb)
    return jnp.swapaxes(o, 0, 1).reshape(B_, Lq, H, v.shape[-1])


def _diff_branch(dq, dk, dv, P, lam_init, ctx_k, ctx_v):
    B_, L, _ = dq.shape
    q = dq.reshape(B_, L, DIFF_HEADS, 2, DIFF_DH)
    k = dk.reshape(B_, L, DIFF_HEADS, 2, DIFF_DH)
    v = dv.reshape(B_, L, DIFF_HEADS, DIFF_DV)
    lp = P['diff_lam'].astype(jnp.float32)
    lam = jnp.exp(jnp.sum(lp[0] * lp[1])) - jnp.exp(jnp.sum(lp[2] * lp[3])) + lam_init
    if ctx_k is None:
        o = _diff_attend(q, k, v, lam)
    else:
        cos, sin = _axial_rope(L)
        ka = jnp.concatenate([ctx_k.astype(k.dtype), _apply_rope(k, cos, sin)], axis=1)
        va = jnp.concatenate([ctx_v.astype(v.dtype), v], axis=1)
        o = _diff_attend(_apply_rope(q, cos, sin), ka, va, lam)
    o = _rms_norm(o, P['diff_norm_g']) * (1.0 - lam_init)
    return o.reshape(B_, L, DIFF_W), k, v


def _mixer(h, P, lam_init, ctx_k, ctx_v, ctx_state):
    B_, L, _ = h.shape
    z = h @ P['w_in']
    zh, gq, gk, gv, gr, glr, dq, dk, dv, zg = jnp.split(z, np.cumsum(IN_SPLITS)[:-1].tolist(), axis=-1)
    ya = _hyena(zh, P)
    if ctx_state is None:
        s0 = jnp.zeros((B_, GLA_HEADS, GLA_DK, GLA_DV), jnp.float32)
        s0f, s0b = s0, s0
    else:
        s0f, s0b = ctx_state[:, 0], ctx_state[:, 1]
    yb, st = _gla_branch(gq, gk, gv, gr, glr, P, s0f, s0b)
    yc, kc, vc = _diff_branch(dq, dk, dv, P, lam_init, ctx_k, ctx_v)
    gates = jax.nn.sigmoid(zg.astype(jnp.float32)).astype(h.dtype).reshape(B_, L, N_BRANCH, D_MODEL)
    y = (gates[:, :, 0] * (ya @ P['w_branch_a'])
         + gates[:, :, 1] * (yb @ P['w_branch_b'])
         + gates[:, :, 2] * (yc @ P['w_branch_c']))
    return y @ P['w_out'], (kc, vc, st)


def _layer(x, cond, P, lam_init, ctx_k=None, ctx_v=None, ctx_state=None):
    mod = (jax.nn.silu(cond) @ P['w_mod'] + P['b_mod']).reshape(cond.shape[0], N_MOD, D_MODEL)[:, :, None, :]
    h = x * (1.0 + mod[:, 1]) + mod[:, 0]
    x = _layer_norm(ALPHA * x + 0.5 * mod[:, 2] * _swiglu(h, P['ffn_w1'][0], P['ffn_w3'][0], P['ffn_w2'][0]),
                    P['ln_g'][0], P['ln_b'][0])
    h = x * (1.0 + mod[:, 4]) + mod[:, 3]
    y, ctx_new = _mixer(h, P, lam_init, ctx_k, ctx_v, ctx_state)
    x = _layer_norm(ALPHA * x + mod[:, 5] * y, P['ln_g'][1], P['ln_b'][1])
    h = x * (1.0 + mod[:, 7]) + mod[:, 6]
    x = _layer_norm(ALPHA * x + 0.5 * mod[:, 8] * _swiglu(h, P['ffn_w1'][1], P['ffn_w3'][1], P['ffn_w2'][1]),
                    P['ln_g'][2], P['ln_b'][2])
    return x, ctx_new


def setup_inputs(seed: int = 0) -> dict:
    key = jax.random.key(seed)
    keys = iter(jax.random.split(key, 40))

    def nrm(shape, scale=1.0):
        return scale * jax.random.normal(next(keys), shape, jnp.float32)

    D = D_MODEL
    FH = HY_FILTER_HIDDEN
    return {
        'x_prompt': nrm((BATCH, SEQ, D)),
        'x_sample': nrm((DEC_BATCH, DEC_SEQ, D)),
        'cache_k': nrm((DEC_BATCH, DEPTH, PAST_LEN, DIFF_HEADS, 2, DIFF_DH)),
        'cache_v': nrm((DEC_BATCH, DEPTH, PAST_LEN, DIFF_HEADS, DIFF_DV)),
        'state_gla': nrm((DEC_BATCH, DEPTH, 2, GLA_HEADS, GLA_DK, GLA_DV)),
        'c': nrm((DEC_BATCH, D)),
        'c_ctx': nrm((D,)),
        'w_mod': nrm((DEPTH, D, N_MOD * D), D ** -0.5),
        'b_mod': nrm((DEPTH, N_MOD * D), 0.02),
        'ln_g': 1.0 + nrm((DEPTH, 3, D), 0.02),
        'ln_b': nrm((DEPTH, 3, D), 0.02),
        'ffn_w1': nrm((DEPTH, 2, D, FFN_DIM), D ** -0.5),
        'ffn_w3': nrm((DEPTH, 2, D, FFN_DIM), D ** -0.5),
        'ffn_w2': nrm((DEPTH, 2, FFN_DIM, D), BETA * FFN_DIM ** -0.5),
        'w_in': nrm((DEPTH, D, IN_COLS), D ** -0.5),
        'hy_conv_w': nrm((DEPTH, HY_SHORT, 3 * HY_W), HY_SHORT ** -0.5),
        'hy_conv_b': nrm((DEPTH, 3 * HY_W), 0.02),
        'hy_w1': nrm((DEPTH, HY_EMB, FH), HY_EMB ** -0.5),
        'hy_b1': nrm((DEPTH, FH), 0.1),
        'hy_freq': 1.0 + nrm((DEPTH, 2, FH), 0.02),
        'hy_w2': nrm((DEPTH, FH, FH), FH ** -0.5),
        'hy_b2': nrm((DEPTH, FH), 0.1),
        'hy_w3': nrm((DEPTH, FH, 4 * HY_W), HY_FILTER_GAIN * FH ** -0.5),
        'hy_decay': jnp.linspace(HY_DECAY_SLOW, HY_DECAY_FAST, 4 * HY_W, dtype=jnp.float32)[None] + nrm((DEPTH, 4 * HY_W), 0.1),
        'hy_bias': nrm((DEPTH, 2, HY_W)),
        'gla_wa': nrm((DEPTH, 2, GLA_RANK, GLA_HEADS * GLA_DK), GLA_RANK ** -0.5),
        'gla_ba': nrm((DEPTH, 2, GLA_HEADS * GLA_DK), 0.1),
        'gla_norm_g': 1.0 + nrm((DEPTH, GLA_DV), 0.02),
        'diff_lam': nrm((DEPTH, 4, DIFF_DH), 0.1),
        'diff_norm_g': 1.0 + nrm((DEPTH, DIFF_DV), 0.02),
        'w_branch_a': nrm((DEPTH, HY_W, D), HY_W ** -0.5),
        'w_branch_b': nrm((DEPTH, GLA_W, D), GLA_W ** -0.5),
        'w_branch_c': nrm((DEPTH, DIFF_W, D), DIFF_W ** -0.5),
        'w_out': nrm((DEPTH, D, D), BETA * D ** -0.5),
    }


def reference(x_prompt, x_sample, cache_k, cache_v, state_gla, c, c_ctx, w_mod, b_mod, ln_g, ln_b,
              ffn_w1, ffn_w3, ffn_w2, w_in, hy_conv_w, hy_conv_b, hy_w1, hy_b1, hy_freq, hy_w2, hy_b2,
              hy_w3, hy_decay, hy_bias, gla_wa, gla_ba, gla_norm_g, diff_lam, diff_norm_g,
              w_branch_a, w_branch_b, w_branch_c, w_out):
    params = [dict(w_mod=w_mod[l], b_mod=b_mod[l], ln_g=ln_g[l], ln_b=ln_b[l], ffn_w1=ffn_w1[l],
                   ffn_w3=ffn_w3[l], ffn_w2=ffn_w2[l], w_in=w_in[l], hy_conv_w=hy_conv_w[l],
                   hy_conv_b=hy_conv_b[l], hy_w1=hy_w1[l], hy_b1=hy_b1[l], hy_freq=hy_freq[l],
                   hy_w2=hy_w2[l], hy_b2=hy_b2[l], hy_w3=hy_w3[l], hy_decay=hy_decay[l],
                   hy_bias=hy_bias[l], gla_wa=gla_wa[l], gla_ba=gla_ba[l], gla_norm_g=gla_norm_g[l],
                   diff_lam=diff_lam[l], diff_norm_g=diff_norm_g[l], w_branch_a=w_branch_a[l],
                   w_branch_b=w_branch_b[l], w_branch_c=w_branch_c[l], w_out=w_out[l])
              for l in range(DEPTH)]
    lam_inits = [0.8 - 0.6 * math.exp(-0.3 * l) for l in range(DEPTH)]

    xp = x_prompt
    ks, vs, ss = [], [], []
    for l in range(DEPTH):
        xp, (kc, vc, sc) = _layer(xp, c_ctx[None], params[l], lam_inits[l])
        ks.append(kc)
        vs.append(vc)
        ss.append(sc)
    new_cache_k = jnp.stack(ks, axis=1)
    new_cache_v = jnp.stack(vs, axis=1)
    new_state_gla = jnp.stack(ss, axis=1)

    xs = x_sample
    for l in range(DEPTH):
        xs, _ = _layer(xs, c, params[l], lam_inits[l], cache_k[:, l], cache_v[:, l], state_gla[:, l])

    return (xp, xs, new_cache_k, new_cache_v, new_state_gla)
```

```cpp
#include <hip/hip_runtime.h>
#include <cstdio>
#include <cstdint>
#ifndef DIAG
#define DIAG 0
#endif
namespace pg8 {
#define PG8_LAS __attribute__((address_space(3)))
typedef unsigned short bf16_t;
typedef short bf16x8 __attribute__((ext_vector_type(8)));
typedef float f32x4 __attribute__((ext_vector_type(4)));
typedef unsigned u32x4 __attribute__((ext_vector_type(4)));
constexpr int BM = 256, BK = 64, HALF = 128, HTB = HALF * BK * 2  , STAGE_BYTES = 8 * HTB, NXCD = 8, WGM = 8;

__host__ __device__ __forceinline__ int lds_byte(int r, int c) { const int st = (r >> 4) * 2 + (c >> 5), rr = r & 15, cc = c & 31, ob = rr * 64 + cc * 2; return st * 1024 + (ob ^ (((ob >> 9) & 1) << 5)); }
__host__ __device__ __forceinline__ void stage_rc(int b, int& R, int& C) { const int st = b / 1024, sb = b % 1024, swz = sb ^ (((sb >> 9) & 1) << 5); R = (st >> 1) * 16 + swz / 64; C = (st & 1) * 32 + (swz % 64) / 2; }
__host__ __device__ __forceinline__ int perm32(int rho) { const int n = rho >> 4, i = rho & 15; return 8 * (i >> 2) + 4 * n + (i & 3); }

struct Unit { int pm, pn; };
struct Gemm { const bf16_t* A; const bf16_t* Bt; int M, N, K; };

struct StaticOrder {
    int nM, nN, nwg, G, c;
    __host__ __device__ void init(int M, int N, int G_, int c_) { nM = M / BM; nN = N / BM; nwg = nM * nN; G = G_; c = c_; }
    __host__ __device__ bool next(int i, Unit& u) const {
        const long L = (long)i * G + c; if (L >= nwg) return false;
        int wgid = (int)L; { const int q = nwg / NXCD, r = nwg % NXCD, xcd = wgid % NXCD, off = wgid / NXCD; wgid = (xcd < r ? xcd * (q + 1) : r * (q + 1) + (xcd - r) * q) + off; }
        const int nig = WGM * nN, gid = wgid / nig, fm = gid * WGM, gsz = (nM - fm) < WGM ? (nM - fm) : WGM;
        u.pm = fm + ((wgid % nig) % gsz); u.pn = (wgid % nig) / gsz; return true;
    }
    __device__ __forceinline__ void a_ready(const Unit&) const {}
    __device__ __forceinline__ void done(const Unit&) const {}
};

__device__ __forceinline__ unsigned cvt_pk_bf16(float lo, float hi) { unsigned r; asm volatile("v_cvt_pk_bf16_f32 %0, %1, %2" : "=v"(r) : "v"(lo), "v"(hi)); return r; }
typedef float f32x2 __attribute__((ext_vector_type(2)));
template <class Epi, class Sched, bool ALIGN_EPI = false, bool SP2 = false>
__device__ __forceinline__ void gemm_phase(PG8_LAS unsigned char* lds, const Gemm g, const Sched& S, const Epi& E) {
    int tid_ = threadIdx.x; asm volatile("" : "+v"(tid_));
    const int tid = tid_, wid = __builtin_amdgcn_readfirstlane(tid >> 6), lane = tid & 63, wr = wid >> 2, wc = wid & 3, fr = lane & 15, fq = lane >> 4;
    const int K = g.K, nt = K / BK;
    unsigned voffA[2], voffB[2];
#pragma unroll
    for (int i = 0; i < 2; ++i) { int R, C; stage_rc(tid * 16 + i * 8192, R, C); const int Rb = Epi::PERM ? ((R & ~31) + perm32(R & 31)) : R;
        voffA[i] = (unsigned)(R * K + C) * 2u; voffB[i] = (unsigned)(Rb * K + C) * 2u; }
    const size_t kstep = (size_t)(BK * 2);
    const size_t hstep = (size_t)HALF * K * 2;
    const size_t tstep = 2 * hstep;
    const unsigned ldsw = (unsigned)wid * 1024u;
    const int aoff = lds_byte(wr * 64 + fr, fq * 8), boff = lds_byte(wc * 32 + fr, fq * 8);
#define PG8_SA(b, h) (((b) * 2 + (h)) * HTB)
#define PG8_SB(b, h) ((4 + (b) * 2 + (h)) * HTB)
#define PG8_STAGE(bufoff, gbase, voff) do { _Pragma("unroll") for (int _i = 0; _i < 2; ++_i) \
        __builtin_amdgcn_global_load_lds((const unsigned*)((const char*)(gbase) + (voff)[_i]), (PG8_LAS unsigned*)(lds + (bufoff) + ldsw + _i * 8192), 16, 0, 0); } while (0)
#define PG8_LDA(dst, b, h) do { _Pragma("unroll") for (int m = 0; m < 4; ++m) _Pragma("unroll") for (int k = 0; k < 2; ++k) dst[m][k] = *(const PG8_LAS bf16x8*)(lds + PG8_SA(b, h) + aoff + m * 2048 + k * 1024); } while (0)
#define PG8_LDB(dst, b, h) do { _Pragma("unroll") for (int n = 0; n < 2; ++n) _Pragma("unroll") for (int k = 0; k < 2; ++k) dst[n][k] = *(const PG8_LAS bf16x8*)(lds + PG8_SB(b, h) + boff + n * 2048 + k * 1024); } while (0)
#define PG8_MMA(ai, bj, At, Bt) do { __builtin_amdgcn_s_setprio(1); _Pragma("unroll") for (int m = 0; m < 4; ++m) _Pragma("unroll") for (int n = 0; n < 2; ++n) _Pragma("unroll") for (int k = 0; k < 2; ++k) \
        acc[ai][bj][m][n] = __builtin_amdgcn_mfma_f32_16x16x32_bf16(Bt[n][k], At[m][k], acc[ai][bj][m][n], 0, 0, 0); __builtin_amdgcn_s_setprio(0); } while (0)
#define PG8_WAIT_V(n) asm volatile("s_waitcnt vmcnt(" #n ")" ::: "memory")
#define PG8_WAIT_L(n) asm volatile("s_waitcnt lgkmcnt(" #n ")" ::: "memory")
#define PG8_BAR __builtin_amdgcn_s_barrier()
#define PG8_SCHED __builtin_amdgcn_sched_barrier(0)
    Unit cur, nxt; int ui = 0;
    if (!S.next(0, cur)) return;
    f32x4 acc[2][2][4][2];
#pragma unroll
    for (int a = 0; a < 2; ++a)
#pragma unroll
        for (int b = 0; b < 2; ++b)
#pragma unroll
            for (int m = 0; m < 4; ++m)
#pragma unroll
                for (int n = 0; n < 2; ++n) acc[a][b][m][n] = (f32x4){0.f, 0.f, 0.f, 0.f};
    bf16x8 At[4][2], B0[2][2], B1[2][2];
    const char* cA = (const char*)g.A + (size_t)cur.pm * tstep; const char* cB = (const char*)g.Bt + (size_t)cur.pn * tstep;
    S.a_ready(cur);
    if constexpr (SP2) {
        PG8_STAGE(PG8_SB(0, 0), cB, voffB); PG8_STAGE(PG8_SB(0, 1), cB + hstep, voffB); PG8_STAGE(PG8_SA(0, 0), cA, voffA); PG8_STAGE(PG8_SA(0, 1), cA + hstep, voffA);
        if (wr == 1) PG8_BAR;
        PG8_WAIT_V(2); PG8_BAR;
        PG8_STAGE(PG8_SB(1, 0), cB + kstep, voffB); PG8_STAGE(PG8_SA(1, 0), cA + kstep, voffA); PG8_STAGE(PG8_SB(1, 1), cB + hstep + kstep, voffB);
        PG8_WAIT_V(6); PG8_BAR;
    } else {
        PG8_STAGE(PG8_SB(0, 0), cB, voffB); PG8_STAGE(PG8_SA(0, 0), cA, voffA); PG8_STAGE(PG8_SB(0, 1), cB + hstep, voffB); PG8_STAGE(PG8_SA(0, 1), cA + hstep, voffA);
        if (wr == 1) PG8_BAR;
        PG8_WAIT_V(4); PG8_BAR;
        PG8_STAGE(PG8_SB(1, 0), cB + kstep, voffB); PG8_STAGE(PG8_SA(1, 0), cA + kstep, voffA); PG8_STAGE(PG8_SB(1, 1), cB + hstep + kstep, voffB);
        PG8_WAIT_V(6); PG8_BAR;
    }
    for (;;) {
        const bool has_next = S.next(ui + 1, nxt);
        const char* nA = has_next ? (const char*)g.A + (size_t)nxt.pm * tstep : cA; const char* nB = has_next ? (const char*)g.Bt + (size_t)nxt.pn * tstep : cB;
        for (int t = 0; t < nt; t += 2) {
            const bool last = (t == nt - 2);
            const char* a1 = cA + (size_t)(t + 1) * kstep;
            const char* a2 = last ? nA : cA + (size_t)(t + 2) * kstep; const char* b2 = last ? nB : cB + (size_t)(t + 2) * kstep;
            const char* a3 = a2 + kstep; const char* b3 = b2 + kstep;
            if (last && has_next) S.a_ready(nxt);
            if constexpr (SP2) {
            PG8_LDB(B0, 0, 0); PG8_LDB(B1, 0, 1); PG8_SCHED; PG8_LDA(At, 0, 0); PG8_STAGE(PG8_SA(1, 1), a1 + hstep, voffA);
            PG8_WAIT_V(8); PG8_WAIT_L(0); PG8_BAR; PG8_MMA(0, 0, At, B0); PG8_MMA(0, 1, At, B1); PG8_BAR; PG8_SCHED;
            PG8_LDA(At, 0, 1); PG8_STAGE(PG8_SB(0, 0), b2, voffB); PG8_STAGE(PG8_SB(0, 1), b2 + hstep, voffB); PG8_STAGE(PG8_SA(0, 0), a2, voffA);
            PG8_WAIT_V(8); PG8_WAIT_L(0); PG8_BAR; PG8_MMA(1, 0, At, B0); PG8_MMA(1, 1, At, B1); PG8_BAR; PG8_SCHED;
            PG8_LDB(B0, 1, 0); PG8_LDB(B1, 1, 1); PG8_SCHED; PG8_LDA(At, 1, 0); PG8_STAGE(PG8_SA(0, 1), a2 + hstep, voffA);
            PG8_WAIT_V(8); PG8_WAIT_L(0); PG8_BAR; PG8_MMA(0, 0, At, B0); PG8_MMA(0, 1, At, B1); PG8_BAR; PG8_SCHED;
            PG8_LDA(At, 1, 1); PG8_STAGE(PG8_SB(1, 0), b3, voffB); PG8_STAGE(PG8_SB(1, 1), b3 + hstep, voffB); PG8_STAGE(PG8_SA(1, 0), a3, voffA);
            PG8_WAIT_V(8); PG8_WAIT_L(0); PG8_BAR; PG8_MMA(1, 0, At, B0); PG8_MMA(1, 1, At, B1); PG8_BAR; PG8_SCHED;
            } else {
            PG8_LDB(B0, 0, 0); PG8_SCHED; PG8_LDA(At, 0, 0); PG8_STAGE(PG8_SA(1, 1), a1 + hstep, voffA);
            PG8_WAIT_L(8); PG8_BAR; PG8_WAIT_L(0); PG8_MMA(0, 0, At, B0); PG8_BAR; PG8_SCHED;
            PG8_LDB(B1, 0, 1); PG8_STAGE(PG8_SB(0, 0), b2, voffB);
            PG8_BAR; PG8_WAIT_L(0); PG8_MMA(0, 1, At, B1); PG8_BAR;
            PG8_LDA(At, 0, 1); PG8_STAGE(PG8_SA(0, 0), a2, voffA);
            PG8_BAR; PG8_WAIT_L(0); PG8_MMA(1, 0, At, B0); PG8_BAR; PG8_SCHED;
            PG8_STAGE(PG8_SB(0, 1), b2 + hstep, voffB);
            PG8_WAIT_V(6); PG8_BAR; PG8_MMA(1, 1, At, B1); PG8_BAR;
            PG8_LDB(B0, 1, 0); PG8_SCHED; PG8_LDA(At, 1, 0); PG8_STAGE(PG8_SA(0, 1), a2 + hstep, voffA);
            PG8_WAIT_L(8); PG8_BAR; PG8_WAIT_L(0); PG8_MMA(0, 0, At, B0); PG8_BAR; PG8_SCHED;
            PG8_LDB(B1, 1, 1); PG8_STAGE(PG8_SB(1, 0), b3, voffB);
            PG8_BAR; PG8_WAIT_L(0); PG8_MMA(0, 1, At, B1); PG8_BAR;
            PG8_LDA(At, 1, 1); PG8_STAGE(PG8_SA(1, 0), a3, voffA);
            PG8_BAR; PG8_WAIT_L(0); PG8_MMA(1, 0, At, B0); PG8_BAR; PG8_SCHED;
            PG8_STAGE(PG8_SB(1, 1), b3 + hstep, voffB);
            PG8_WAIT_V(6); PG8_BAR; PG8_MMA(1, 1, At, B1); PG8_BAR;
            }
        }
        if constexpr (ALIGN_EPI) { if (wr == 0) PG8_BAR; }
        if constexpr (!Epi::AFTER_DRAIN) { E(acc, cur, wr, wc, fr, fq); S.done(cur); }
        if (!has_next) break;
#pragma unroll
        for (int a = 0; a < 2; ++a)
#pragma unroll
            for (int b = 0; b < 2; ++b)
#pragma unroll
                for (int m = 0; m < 4; ++m)
#pragma unroll
                    for (int n = 0; n < 2; ++n) acc[a][b][m][n] = (f32x4){0.f, 0.f, 0.f, 0.f};
        cur = nxt; cA = nA; cB = nB; ++ui;
        if constexpr (ALIGN_EPI) { if (wr == 1) PG8_BAR; }
    }
    PG8_WAIT_V(0);
    if constexpr (!ALIGN_EPI) { if (wr == 0) PG8_BAR; }
    PG8_BAR;
    if constexpr (Epi::AFTER_DRAIN) { E.fused(acc, cur, wr, wc, fr, fq, lds, wid, lane); S.done(cur); }
#undef PG8_SA
#undef PG8_SB
#undef PG8_STAGE
#undef PG8_LDA
#undef PG8_LDB
#undef PG8_MMA
#undef PG8_WAIT_V
#undef PG8_WAIT_L
#undef PG8_BAR
#undef PG8_SCHED
}
}
constexpr int D = 2048, FF = 5504, NCTXB = 16, LCTX = 256, NLATB = 8, LLAT = 4096, DEPTH = 2;
constexpr int RCTX = NCTXB * LCTX  , RLAT = NLATB * LLAT  , MTOT = RCTX + RLAT  ;
constexpr int NMODV = 9, NMOD = 9 * D  ;
constexpr int HYW = 1024, FH = 64, HYEMB = 17;
constexpr int GH = 4, GDK = 128, GDV = 256, GRANK = 16;
constexpr int AH = 8, ADH = 64, ADV = 128;
constexpr int INC = 15392, INP = 15616;
constexpr int NCHUNK = 5;
constexpr float ALPHA = 1.4142135623730951f;
constexpr float LN_EPS = 1e-5f, RMS_EPS = 1e-6f;
constexpr float LOG2E = 1.4426950408889634f;
enum { I_XP = 0, I_XS, I_CK, I_CV, I_SG, I_C, I_CCTX, I_WMOD, I_BMOD, I_LNG, I_LNB, I_W1, I_W3, I_W2, I_WIN, I_HCW, I_HCB, I_HW1, I_HB1, I_HFREQ, I_HW2, I_HB2,
       I_HW3, I_HDEC, I_HBIAS, I_GWA, I_GBA, I_GNG, I_DLAM, I_DNG, I_WBA, I_WBB, I_WBC, I_WOUT, N_IN };
constexpr size_t O_YP = 0, O_YS = (size_t)RCTX * D, O_NCK = (size_t)MTOT * D, O_NCV = O_NCK + 8388608, O_NSG = O_NCV + 8388608, O_END = O_NSG + 8388608;
constexpr size_t MiB = 1u << 20;
constexpr size_t WS_CTL = 0, CTL_ZERO_BYTES = 1 * MiB;
constexpr size_t WS_MOD = 1 * MiB;
constexpr size_t WS_ROPE = 3 * MiB;
constexpr size_t WS_HDN = 4 * MiB;
constexpr size_t WS_CKB = 8 * MiB;
constexpr size_t WS_CVT = 16 * MiB;
constexpr size_t WS_TW = 24 * MiB;
constexpr size_t WS_W = 25 * MiB;
constexpr size_t WL_W13 = 0, WL_W2 = 86 * MiB, WL_WIN = 129 * MiB, WL_WA = 190 * MiB, WL_WB = 194 * MiB, WL_WC = 198 * MiB, WL_WO = 202 * MiB, WL_STRIDE = 210 * MiB;
constexpr size_t WS_FILT = WS_W + 2 * WL_STRIDE;
constexpr size_t WS_H = WS_FILT + 68 * MiB;
constexpr size_t WS_BIG = WS_H + 144 * MiB;
constexpr size_t WS_U = WS_BIG;
constexpr size_t MX_ZHT = WS_BIG;
constexpr size_t MX_GQ = MX_ZHT + 48 * MiB;
constexpr size_t MX_GK = MX_GQ + 8 * MiB;
constexpr size_t MX_GVT = MX_GK + 8 * MiB;
constexpr size_t MX_GR = MX_GVT + 16 * MiB;
constexpr size_t MX_GLR = MX_GR + 16 * MiB;
constexpr size_t MX_DQ = MX_GLR + 1 * MiB;
constexpr size_t MX_DK = MX_DQ + 16 * MiB;
constexpr size_t MX_DVT = MX_DK + 16 * MiB;
constexpr size_t MX_GT = MX_DVT + 16 * MiB;
constexpr size_t MX_OF = MX_GT + 96 * MiB;
constexpr size_t MX_OB = MX_OF + 32 * MiB;
constexpr size_t MX_YAT = MX_OB + 32 * MiB;
constexpr size_t MX_YA = MX_YAT + 16 * MiB;
constexpr size_t MX_YB = MX_YA + 16 * MiB;
constexpr size_t MX_YC = MX_YB + 16 * MiB;
constexpr size_t MX_YACC = MX_YC + 16 * MiB;
constexpr size_t MX_Y16 = MX_YACC + 64 * MiB;
constexpr size_t MX_END = MX_Y16 + 32 * MiB;
constexpr size_t WS_END = (MX_END > WS_U + 388 * MiB) ? MX_END : WS_U + 388 * MiB;
static_assert(WS_END <= 1152 * MiB, "workspace map must stay under 4 x the largest tensor");
constexpr int CW_TMO = 0, CW_ERR = 64  , CW_BAR = 4096;
constexpr int NWAVES = 8;
constexpr int RING_OFF = 0, RING_BYTES = 147456;
constexpr int LDSCTL_OFF = RING_BYTES, MISC_OFF = LDSCTL_OFF + 320;
constexpr int LDS_BYTES = RING_BYTES + 4096;
#define GAS __attribute__((address_space(1)))
#define LAS __attribute__((address_space(3)))
typedef unsigned short bf16;
typedef unsigned v4u __attribute__((ext_vector_type(4)));
typedef float f32x4 __attribute__((ext_vector_type(4)));
typedef short bf16x8 __attribute__((ext_vector_type(8)));
typedef GAS unsigned gu32;
typedef GAS unsigned long long gu64;
#define RLX_AGENT __ATOMIC_RELAXED, __HIP_MEMORY_SCOPE_AGENT
#define LDS_WAIT() asm volatile("s_waitcnt lgkmcnt(0)" ::: "memory")
#define VM_WAIT() asm volatile("s_waitcnt vmcnt(0)" ::: "memory")
__device__ __forceinline__ unsigned long long rt() { return __builtin_amdgcn_s_memrealtime(); }
__device__ __forceinline__ unsigned f2bf(float f) { unsigned u = __builtin_bit_cast(unsigned, f); return (u + 0x7fffu + ((u >> 16) & 1u)) >> 16; }
__device__ __forceinline__ unsigned pk2(float lo, float hi) { return f2bf(lo) | (f2bf(hi) << 16); }

#define XB_TMO      128
#define XB_XCNT(j)  (256  + 64 * (j))
#define XB_XSUB(j)  (1280 + 64 * (j))
#define XB_XGEN(j)  (2304 + 64 * (j))
#define XB_TOP      3328
#define XB_TOPGEN   3392
#define XCD_BAR_WORDS 3456
#define XB_SPIN_CAP (1u << 18)

__device__ __forceinline__ unsigned xb_ld(unsigned* p)              { return __hip_atomic_load(p, __ATOMIC_RELAXED, __HIP_MEMORY_SCOPE_AGENT); }
__device__ __forceinline__ unsigned xb_add(unsigned* p, unsigned v) { return __hip_atomic_fetch_add(p, v, __ATOMIC_RELAXED, __HIP_MEMORY_SCOPE_AGENT); }
__device__ __forceinline__ unsigned xb_xcc_id() { return (unsigned)__builtin_amdgcn_s_getreg((3 << 11) | 20) & 0xFu; }
#define XB_SPIN(cond, bar) do { unsigned _sp = 0; while (cond) { __builtin_amdgcn_s_sleep(1); \
    if ((++_sp & 255u) == 0u) { if (xb_ld(&(bar)[XB_TMO])) break; if (_sp > XB_SPIN_CAP) { atomicAdd(&(bar)[XB_TMO], 1u); break; } } } } while (0)

struct XcdBarrier {
    unsigned* bar; unsigned x;
    volatile LAS unsigned* st;
};

__device__ __forceinline__ XcdBarrier xcd_barrier_post(unsigned* bar, volatile LAS unsigned* st) {
    XcdBarrier b; b.bar = bar; b.x = xb_xcc_id(); b.st = st;
    if (threadIdx.x == 0) (void)xb_add(&bar[XB_XCNT(b.x)], 1u);
    return b;
}
__device__ __forceinline__ void xcd_barrier_complete(unsigned* bar, unsigned x, unsigned& nloc, unsigned& nx) {
    const unsigned G = gridDim.x * gridDim.y * gridDim.z;
    unsigned sum, cnt, mine, sp = 0u;
    for (;;) {
        sum = 0u; cnt = 0u; mine = 0u;
#pragma unroll
        for (unsigned j = 0; j < 16; ++j) { const unsigned c = xb_ld(&bar[XB_XCNT(j)]); sum += c; cnt += (c > 0u) ? 1u : 0u; mine = (j == x) ? c : mine; }
        if (sum == G) break;
        __builtin_amdgcn_s_sleep(1);
        if ((++sp & 255u) == 0u) { if (xb_ld(&bar[XB_TMO])) break; if (sp > XB_SPIN_CAP) { atomicAdd(&bar[XB_TMO], 1u); break; } }
    }
    nloc = mine > 0u ? mine : 1u; nx = cnt > 0u ? cnt : 1u;
}

__device__ __forceinline__ void xcd_barrier(const XcdBarrier& b) {
    asm volatile("s_waitcnt vmcnt(0)" ::: "memory");
    __syncthreads();
    if (threadIdx.x == 0) {
        unsigned* bar = b.bar;
        __builtin_amdgcn_s_waitcnt(0);
        unsigned nloc = b.st[0], nx = b.st[1];
        if (nloc == 0u) { xcd_barrier_complete(bar, b.x, nloc, nx); b.st[0] = nloc; b.st[1] = nx; }
        const unsigned old = xb_add(&bar[XB_XSUB(b.x)], 1u);
        const unsigned gen = old / nloc;
        if (old + 1u == (gen + 1u) * nloc) {
            __builtin_amdgcn_fence(__ATOMIC_RELEASE, "agent");
            asm volatile("s_waitcnt vmcnt(0)" ::: "memory");
            const unsigned og = xb_add(&bar[XB_TOP], 1u);
            const unsigned tg = og / nx;
            if (og + 1u == (tg + 1u) * nx) xb_add(&bar[XB_TOPGEN], 1u);
            else XB_SPIN(xb_ld(&bar[XB_TOPGEN]) == tg, bar);
            __builtin_amdgcn_fence(__ATOMIC_ACQUIRE, "agent");
            xb_add(&bar[XB_XGEN(b.x)], 1u);
            asm volatile("s_waitcnt vmcnt(0)" ::: "memory");
        } else {
            XB_SPIN(xb_ld(&bar[XB_XGEN(b.x)]) == gen, bar);
            __builtin_amdgcn_fence(__ATOMIC_ACQUIRE, "agent");
            asm volatile("s_waitcnt vmcnt(0)" ::: "memory");
        }
    }
    __syncthreads();
}
namespace pg8 {
__device__ __forceinline__ float fast_rcp(float x) { return __builtin_amdgcn_rcpf(x); }
__device__ __forceinline__ float sigmoid_f(float x) { return fast_rcp(1.0f + __builtin_amdgcn_exp2f(-x * 1.4426950408889634f)); }
__device__ __forceinline__ float silu_f(float x) { return x * sigmoid_f(x); }
__device__ __forceinline__ unsigned short bf1(float f) { unsigned u = __builtin_bit_cast(unsigned, f); return (unsigned short)((u + 0x7fffu + ((u >> 16) & 1u)) >> 16); }
__device__ __forceinline__ int mod_of_tile(int gpm) { return gpm < 16 ? 0 : 1 + ((gpm - 16) >> 4); }

struct EpiSwiglu {
    static constexpr bool PERM = true, AFTER_DRAIN = false;
    bf16_t* U; int ldu;
    __device__ __forceinline__ void operator()(const f32x4 (&acc)[2][2][4][2], const Unit& u, int wr, int wc, int fr, int fq) const {
        const int row0 = u.pm * BM + wr * 64 + fr, col0 = u.pn * 128 + wc * 32 + 8 * fq;
#pragma unroll
        for (int ai = 0; ai < 2; ++ai)
#pragma unroll
            for (int m = 0; m < 4; ++m) {
                const f32x4 a0 = acc[ai][0][m][0], a1 = acc[ai][0][m][1], b0 = acc[ai][1][m][0], b1 = acc[ai][1][m][1];
                u32x4 w;
                w.x = cvt_pk_bf16(silu_f(a0[0]) * b0[0], silu_f(a0[1]) * b0[1]); w.y = cvt_pk_bf16(silu_f(a0[2]) * b0[2], silu_f(a0[3]) * b0[3]);
                w.z = cvt_pk_bf16(silu_f(a1[0]) * b1[0], silu_f(a1[1]) * b1[1]); w.w = cvt_pk_bf16(silu_f(a1[2]) * b1[2], silu_f(a1[3]) * b1[3]);
                *(u32x4*)(U + (size_t)(row0 + ai * HALF + m * 16) * ldu + col0) = w;
            }
    }
};
struct EpiResid {
    static constexpr bool PERM = false, AFTER_DRAIN = false;
    const float* xs_ctx; const float* xs_lat;
    float* X; const float* gate;
    int pm0; float gs;
    __device__ __forceinline__ void operator()(const f32x4 (&acc)[2][2][4][2], const Unit& u, int wr, int wc, int fr, int fq) const {
        const int gpm = u.pm + pm0; const float* g = gate + (size_t)mod_of_tile(gpm) * NMOD;
        const int row0 = gpm * BM + wr * 64 + fr, col0 = u.pn * BM + wc * 32 + 4 * fq;
        f32x4 gv[2][2];
#pragma unroll
        for (int bj = 0; bj < 2; ++bj)
#pragma unroll
            for (int n = 0; n < 2; ++n) gv[bj][n] = *(const f32x4*)(g + col0 + bj * HALF + n * 16) * gs;
#pragma unroll
        for (int ai = 0; ai < 2; ++ai)
#pragma unroll
            for (int m = 0; m < 4; ++m) {
                const int row = row0 + ai * HALF + m * 16;
                const float* src = (row < RCTX ? xs_ctx + (size_t)row * D : xs_lat + (size_t)(row - RCTX) * D) + col0;
                float* dst = X + (size_t)row * D + col0;
#pragma unroll
                for (int bj = 0; bj < 2; ++bj)
#pragma unroll
                    for (int n = 0; n < 2; ++n) { const f32x4 xv = *(const f32x4*)(src + bj * HALF + n * 16);
                        *(f32x4*)(dst + bj * HALF + n * 16) = xv * ALPHA + gv[bj][n] * acc[ai][bj][m][n]; }
            }
    }
};
struct EpiBranch {
    static constexpr bool PERM = false, AFTER_DRAIN = false;
    const bf16_t* Gt; int gcol0; float* Yacc; bf16_t* Y16; int mode;
    __device__ __forceinline__ void operator()(const f32x4 (&acc)[2][2][4][2], const Unit& u, int wr, int wc, int fr, int fq) const {
        const int row0 = u.pm * BM + wr * 64 + fr, col0 = u.pn * BM + wc * 32 + 4 * fq;
#pragma unroll
        for (int ai = 0; ai < 2; ++ai)
#pragma unroll
            for (int m = 0; m < 4; ++m) {
                const size_t row = (size_t)(row0 + ai * HALF + m * 16);
#pragma unroll
                for (int bj = 0; bj < 2; ++bj)
#pragma unroll
                    for (int n = 0; n < 2; ++n) { const int c = col0 + bj * HALF + n * 16;
                        const uint2 gw = *(const uint2*)(Gt + row * 6144 + gcol0 + c);
                        f32x4 g; g[0] = __uint_as_float(gw.x << 16); g[1] = __uint_as_float(gw.x & 0xffff0000u); g[2] = __uint_as_float(gw.y << 16); g[3] = __uint_as_float(gw.y & 0xffff0000u);
                        f32x4 v = g * acc[ai][bj][m][n];
                        if (mode != 0) v += *(const f32x4*)(Yacc + row * D + c);
                        if (mode != 2) *(f32x4*)(Yacc + row * D + c) = v;
                        else { uint2 o; o.x = cvt_pk_bf16(v[0], v[1]); o.y = cvt_pk_bf16(v[2], v[3]); *(uint2*)(Y16 + row * D + c) = o; } }
            }
    }
};
struct EpiWin {
    static constexpr bool PERM = false, AFTER_DRAIN = false;
    unsigned char* ws;
    float *nck, *ncv;
    int L, lshift;
    __device__ __forceinline__ void operator()(const f32x4 (&acc)[2][2][4][2], const Unit& u, int wr, int wc, int fr, int fq) const {
        const int pn = u.pn; const int row0 = u.pm * BM + wr * 64 + fr;
        const int cw = wc * 32 + 4 * fq;
        if (pn < 12 || (pn >= 16 && pn < 20) || (pn >= 32 && pn < 36)) {
            bf16_t* T; int W, cb;
            if (pn < 12) { T = (bf16_t*)(ws + MX_ZHT); W = 3072; cb = pn * 256; } else if (pn < 20) { T = (bf16_t*)(ws + MX_GVT); W = 1024; cb = (pn - 16) * 256; } else { T = (bf16_t*)(ws + MX_DVT); W = 1024; cb = (pn - 32) * 256; }
            const bool cache = (pn >= 32) && (ncv != nullptr);
            const unsigned Lu = (unsigned)L;
#pragma unroll
            for (int ai = 0; ai < 2; ++ai)
#pragma unroll
                for (int m = 0; m < 4; ++m) { const int rl = row0 + ai * HALF + m * 16; const int b = rl >> lshift, t = rl & (L - 1);
                    bf16_t* Tr = T + ((size_t)b * W + cb + cw) * Lu + t;
#pragma unroll
                    for (int bj = 0; bj < 2; ++bj)
#pragma unroll
                        for (int n = 0; n < 2; ++n) { const f32x4 v = acc[ai][bj][m][n]; const unsigned co = (unsigned)(bj * HALF + n * 16) * Lu;
#pragma unroll
                            for (int i = 0; i < 4; ++i) Tr[co + (unsigned)i * Lu] = bf1(v[i]);
                            if (cache) *(f32x4*)(ncv + ((size_t)b * 2 * 256 + t) * 1024 + cb + bj * HALF + cw + n * 16) = v; } }
            return;
        }
        if (pn == 60) {
            if (wc == 0) {
#pragma unroll
                for (int ai = 0; ai < 2; ++ai)
#pragma unroll
                    for (int m = 0; m < 4; ++m) { const int rl = row0 + ai * HALF + m * 16;
#pragma unroll
                        for (int n = 0; n < 2; ++n) *(f32x4*)((float*)(ws + MX_GLR) + (size_t)rl * 32 + 4 * fq + n * 16) = acc[ai][0][m][n]; } }
            return;
        }
        if (pn >= 24 && pn < 32) {
            const bool isq = pn < 28; bf16_t* O = (bf16_t*)(ws + (isq ? MX_DQ : MX_DK)); const float* rope = (const float*)(ws + WS_ROPE); const int cb = (pn - (isq ? 24 : 28)) * 256;
            const float sc = isq ? 0.125f * LOG2E : 1.0f; const bool lat = (nck == nullptr);
#pragma unroll
            for (int ai = 0; ai < 2; ++ai)
#pragma unroll
                for (int m = 0; m < 4; ++m) { const int rl = row0 + ai * HALF + m * 16; const int t = rl & (L - 1);
                    f32x4 cs = {1.f, 1.f, 1.f, 1.f}, sn = {0.f, 0.f, 0.f, 0.f};
                    if (lat) { cs = *(const f32x4*)(rope + (size_t)t * 32 + (wc & 1) * 16 + 4 * fq); sn = *(const f32x4*)(rope + 4096 * 32 + (size_t)t * 32 + (wc & 1) * 16 + 4 * fq); }
#pragma unroll
                    for (int bj = 0; bj < 2; ++bj) { const f32x4 x1 = acc[ai][bj][m][0], x2 = acc[ai][bj][m][1]; const int c = cb + bj * HALF + cw;
                        if (!isq && !lat) { const int b = rl >> lshift; float* kc = nck + ((size_t)b * 2 * 256 + t) * 1024 + c; *(f32x4*)kc = x1; *(f32x4*)(kc + 16) = x2; }
                        const f32x4 o1 = (x1 * cs - x2 * sn) * sc, o2 = (x1 * sn + x2 * cs) * sc;
                        uint2 w1; w1.x = cvt_pk_bf16(o1[0], o1[1]); w1.y = cvt_pk_bf16(o1[2], o1[3]); uint2 w2; w2.x = cvt_pk_bf16(o2[0], o2[1]); w2.y = cvt_pk_bf16(o2[2], o2[3]);
                        *(uint2*)(O + (size_t)rl * 1024 + c) = w1; *(uint2*)(O + (size_t)rl * 1024 + c + 16) = w2; } }
            return;
        }
        bf16_t* O; int ld, cb, act;
        if (pn < 14) { O = (bf16_t*)(ws + MX_GQ); ld = 512; cb = (pn - 12) * 256; act = 1; } else if (pn < 16) { O = (bf16_t*)(ws + MX_GK); ld = 512; cb = (pn - 14) * 256; act = 0; }
        else if (pn < 24) { O = (bf16_t*)(ws + MX_GR); ld = 1024; cb = (pn - 20) * 256; act = 2; } else { O = (bf16_t*)(ws + MX_GT); ld = 6144; cb = (pn - 36) * 256; act = 3; }
#pragma unroll
        for (int ai = 0; ai < 2; ++ai)
#pragma unroll
            for (int m = 0; m < 4; ++m) { const int rl = row0 + ai * HALF + m * 16;
#pragma unroll
                for (int bj = 0; bj < 2; ++bj)
#pragma unroll
                    for (int n = 0; n < 2; ++n) { f32x4 v = acc[ai][bj][m][n];
                        if (act == 1) v = v * 0.08838834764831845f;
                        else if (act == 2) { v[0] = silu_f(v[0]); v[1] = silu_f(v[1]); v[2] = silu_f(v[2]); v[3] = silu_f(v[3]); }
                        else if (act == 3) { v[0] = sigmoid_f(v[0]); v[1] = sigmoid_f(v[1]); v[2] = sigmoid_f(v[2]); v[3] = sigmoid_f(v[3]); }
                        uint2 w; w.x = cvt_pk_bf16(v[0], v[1]); w.y = cvt_pk_bf16(v[2], v[3]);
                        *(uint2*)(O + (size_t)rl * ld + cb + bj * HALF + cw + n * 16) = w; } }
    }
};
}
typedef float f32x2g __attribute__((ext_vector_type(2)));
typedef unsigned u32x2 __attribute__((ext_vector_type(2)));
struct Args { const float* in[N_IN]; float* out; unsigned char* ws; };
typedef const __attribute__((address_space(4))) Args* CArgsP;
struct InTab { CArgsP ap; __device__ __forceinline__ const float* operator[](int i) const { return ap->in[i]; } };
struct Frame {
    LAS unsigned char* lds; volatile LAS unsigned* MISC; gu32* ctl;
    int tid, lane, wave, G, gw, NGW;
    InTab in; float* out; unsigned char* ws;
};
__device__ __forceinline__ Frame make_frame() {
    CArgsP ap = (CArgsP)__builtin_amdgcn_kernarg_segment_ptr(); asm volatile("" : "+s"(ap));
    extern __shared__ __attribute__((aligned(16))) unsigned char lds_raw[];
    Frame F; F.lds = (LAS unsigned char*)lds_raw; F.MISC = (volatile LAS unsigned*)(F.lds + MISC_OFF);
    { int t_ = threadIdx.x; asm volatile("" : "+v"(t_)); F.tid = t_; } F.lane = F.tid & 63; F.wave = __builtin_amdgcn_readfirstlane(F.tid >> 6);
    F.G = gridDim.x; F.gw = blockIdx.x * NWAVES + F.wave; F.NGW = F.G * NWAVES;
    F.in.ap = ap; F.out = ap->out; F.ws = ap->ws; F.ctl = (gu32*)(F.ws + WS_CTL);
    return F;
}
__device__ __forceinline__ float shflx(float v, int mask, int lane) { return __uint_as_float((unsigned)__builtin_amdgcn_ds_bpermute((lane ^ mask) << 2, (int)__float_as_uint(v))); }
__device__ __forceinline__ float wave_sum(float v, int lane) {
#pragma unroll
    for (int o = 1; o < 64; o <<= 1) v += shflx(v, o, lane);
    return v;
}
__device__ __forceinline__ float bf2f(bf16 h) { return __uint_as_float((unsigned)h << 16); }
__device__ __forceinline__ bf16 f2b(float f) { return (bf16)f2bf(f); }
__device__ __forceinline__ float sigmoidf_(float x) { return 1.0f / (1.0f + __expf(-x)); }
__device__ __forceinline__ float siluf_(float x) { return x * sigmoidf_(x); }
__device__ __forceinline__ bf16* wsb(const Frame& F, size_t off) { return (bf16*)(F.ws + off); }
__device__ __forceinline__ float* wsf(const Frame& F, size_t off) { return (float*)(F.ws + off); }
__device__ __forceinline__ int mod_of_row(int row) { return row < RCTX ? 0 : 1 + ((row - RCTX) >> 12); }
__device__ __forceinline__ const float* xin_row(const Frame& F, int row) { return row < RCTX ? F.in[I_XP] + (size_t)row * D : F.in[I_XS] + (size_t)(row - RCTX) * D; }

__device__ __forceinline__ void transpose_item(const float* src, int ldn, int K, bf16* dst, int k0, LAS float* scr, int lane) {
    if (src == nullptr) {
        const int c = lane & 7;
#pragma unroll
        for (int j = 0; j < 4; ++j) { const int n = (lane >> 3) + 8 * j; *(GAS v4u*)(dst + (size_t)n * K + k0 + 8 * c) = (v4u){0u, 0u, 0u, 0u}; }
        return;
    }
#pragma unroll 8
    for (int i = 0; i < 32; ++i) { const int kk = 2 * i + (lane >> 5); scr[kk * 33 + (lane & 31)] = src[(size_t)(k0 + kk) * ldn + (lane & 31)]; }
    LDS_WAIT(); asm volatile("" ::: "memory");
    const int c = lane & 7;
#pragma unroll
    for (int j = 0; j < 4; ++j) { const int n = (lane >> 3) + 8 * j; const LAS float* s = scr + (8 * c) * 33 + n;
        v4u o; o.x = pk2(s[0 * 33], s[1 * 33]); o.y = pk2(s[2 * 33], s[3 * 33]); o.z = pk2(s[4 * 33], s[5 * 33]); o.w = pk2(s[6 * 33], s[7 * 33]);
        *(GAS v4u*)(dst + (size_t)n * K + k0 + 8 * c) = o; }
    LDS_WAIT(); asm volatile("" ::: "memory");
}
constexpr int IT_W13 = 2 * 344 * 32, IT_W2 = 2 * 64 * 86, IT_WIN = 488 * 32, IT_BR = 64 * 16, IT_WO = 64 * 32, IT_LAYER = IT_W13 + IT_W2 + IT_WIN + 3 * IT_BR + IT_WO;
__device__ __forceinline__ void convert_item(const Frame& F, int l, int it, LAS float* scr) {
    unsigned char* wl = F.ws + WS_W + (size_t)l * WL_STRIDE;
    if (it < IT_W13) { const int s = it / (344 * 32), r = it % (344 * 32), nb = r / 32, kb = r % 32; const int n0 = nb * 32, pn = n0 >> 8, j = n0 & 255;
        const float* src = (j < 128 ? F.in[I_W1] : F.in[I_W3]) + ((size_t)(l * 2 + s) * D) * FF + pn * 128 + (j & 127);
        transpose_item(src, FF, D, (bf16*)(wl + WL_W13) + ((size_t)s * 11008 + n0) * D, kb * 64, scr, F.lane); return; }
    it -= IT_W13;
    if (it < IT_W2) { const int s = it / (64 * 86), r = it % (64 * 86), nb = r / 86, kb = r % 86;
        const float* src = F.in[I_W2] + ((size_t)(l * 2 + s) * FF) * D + nb * 32;
        transpose_item(src, D, FF, (bf16*)(wl + WL_W2) + ((size_t)s * D + nb * 32) * FF, kb * 64, scr, F.lane); return; }
    it -= IT_W2;
    if (it < IT_WIN) { const int nb = it / 32, kb = it % 32, n0 = nb * 32;
        int oc = n0 < 6144 ? n0 : (n0 < 15360 ? n0 + 32 : (n0 < INC ? n0 - 15360 + 6144 : -1));
        const float* src = oc >= 0 ? F.in[I_WIN] + (size_t)l * D * INC + oc : nullptr;
        transpose_item(src, INC, D, (bf16*)(wl + WL_WIN) + (size_t)n0 * D, kb * 64, scr, F.lane); return; }
    it -= IT_WIN;
    if (it < 3 * IT_BR) { const int w = it / IT_BR, r = it % IT_BR, nb = r / 16, kb = r % 16;
        const float* src = F.in[I_WBA + w] + (size_t)l * 1024 * D + nb * 32;
        transpose_item(src, D, 1024, (bf16*)(wl + WL_WA + (size_t)w * 4 * MiB) + (size_t)nb * 32 * 1024, kb * 64, scr, F.lane); return; }
    it -= 3 * IT_BR;
    { const int nb = it / 32, kb = it % 32;
        const float* src = F.in[I_WOUT] + (size_t)l * D * D + nb * 32;
        transpose_item(src, D, D, (bf16*)(wl + WL_WO) + (size_t)nb * 32 * D, kb * 64, scr, F.lane); }
}
__device__ __forceinline__ void mod_unit(const Frame& F, int unit) {
    LAS float* sc = (LAS float*)(F.lds);
    LAS float* red = (LAS float*)(F.lds + 9 * D * 4);
    const int l = unit / 144, n0 = (unit % 144) * 128;
    for (int i = F.tid; i < 9 * D; i += 512) { const int m = i / D, k = i % D; const float c = m == 0 ? F.in[I_CCTX][k] : F.in[I_C][(size_t)(m - 1) * D + k]; sc[i] = siluf_(c); }
    __syncthreads();
    float a0[9], a1[9];
#pragma unroll
    for (int m = 0; m < 9; ++m) { a0[m] = 0.f; a1[m] = 0.f; }
    const float* w = F.in[I_WMOD] + ((size_t)l * D + F.wave * 256) * NMOD + n0 + 2 * F.lane;
#pragma unroll 4
    for (int k = 0; k < 256; ++k) { const float2 wv = *(const float2*)(w + (size_t)k * NMOD);
#pragma unroll
        for (int m = 0; m < 9; ++m) { const float s = sc[m * D + F.wave * 256 + k]; a0[m] += s * wv.x; a1[m] += s * wv.y; } }
#pragma unroll
    for (int m = 0; m < 9; ++m) { red[(F.wave * 9 + m) * 128 + 2 * F.lane] = a0[m]; red[(F.wave * 9 + m) * 128 + 2 * F.lane + 1] = a1[m]; }
    __syncthreads();
    for (int i = F.tid; i < 9 * 128; i += 512) { const int m = i / 128, c = i % 128; float s = F.in[I_BMOD][(size_t)l * NMOD + n0 + c];
#pragma unroll
        for (int wv = 0; wv < 8; ++wv) s += red[(wv * 9 + m) * 128 + c];
        wsf(F, WS_MOD)[((size_t)l * 9 + m) * NMOD + n0 + c] = s; }
    __syncthreads();
}
__device__ __forceinline__ void p0_prologue(const Frame& F) {
    for (int u = blockIdx.x; u < 2 * 144; u += F.G) mod_unit(F, u);
    LAS float* scr = (LAS float*)(F.lds + F.wave * 16384);
    for (int it = F.gw; it < 2 * IT_LAYER; it += F.NGW) convert_item(F, it / IT_LAYER, it % IT_LAYER, scr);
    const int gt = blockIdx.x * 512 + F.tid, NGT = F.G * 512;
    { float* rp = wsf(F, WS_ROPE);
      for (int i = gt; i < 4096 * 32; i += NGT) { const int t = i >> 5, ax = (i >> 4) & 1, f = i & 15; const float inv = powf(10000.0f, -(float)f / 16.0f);
          const float pos = (float)(ax == 0 ? (t >> 6) : (t & 63)); const float ang = pos * inv; rp[i] = cosf(ang); rp[4096 * 32 + i] = sinf(ang); } }
    { f32x2g* tw = (f32x2g*)(F.ws + WS_TW);
      for (int i = gt; i < 8192; i += NGT) { float s, c; sincospif(-(float)i / 4096.0f, &s, &c); tw[i] = (f32x2g){c, s}; } }
    { bf16* ck = wsb(F, WS_CKB); const float* src = F.in[I_CK];
      for (int i = gt; i < 2 * 8 * 256 * 1024; i += NGT) { const int c = i & 1023, t = (i >> 10) & 255, b = (i >> 18) & 7, l = i >> 21;
          ck[i] = f2b(src[(((size_t)b * 2 + l) * 256 + t) * 1024 + c]); } }
    { bf16* cv = wsb(F, WS_CVT); const float* src = F.in[I_CV];
      for (int i = gt; i < 2 * 8 * 256 * 1024; i += NGT) { const int t = i & 255, c = (i >> 8) & 1023, b = (i >> 18) & 7, l = i >> 21;
          cv[i] = f2b(src[(((size_t)b * 2 + l) * 256 + t) * 1024 + c]); } }
    { float* hd = wsf(F, WS_HDN);
      for (int r = F.gw; r < 2 * (256 + 4096); r += F.NGW) { const int l = r / 4352, q = r % 4352, ls = q < 256 ? 0 : 1, t = ls ? q - 256 : q, L = ls ? 4096 : 256;
          const float tt = (float)t / (float)(L - 1), w = (6.283185307179586f / (float)L) * (float)t; const int j = F.lane;
          const float* w1 = F.in[I_HW1] + (size_t)l * HYEMB * FH; float a = F.in[I_HB1][l * FH + j] + tt * w1[j];
#pragma unroll
          for (int m = 0; m < 8; ++m) { const float f = 1e-4f + (float)m * ((7.0f - 1e-4f) / 7.0f); const float ph = w * f; a += cosf(ph) * w1[(1 + m) * FH + j] - sinf(ph) * w1[(9 + m) * FH + j]; }
          const float h1 = sinf(F.in[I_HFREQ][(l * 2 + 0) * FH + j] * a);
          float a2 = F.in[I_HB2][l * FH + j]; const float* w2 = F.in[I_HW2] + (size_t)l * FH * FH;
          for (int i = 0; i < 64; ++i) a2 += __uint_as_float((unsigned)__builtin_amdgcn_readlane((int)__float_as_uint(h1), i)) * w2[i * FH + j];
          hd[(((size_t)l * 2 + ls) * 4096 + t) * FH + j] = sinf(F.in[I_HFREQ][(l * 2 + 1) * FH + j] * a2); } }
}
__device__ __forceinline__ void p0_h0(const Frame& F) {
    const float* md = wsf(F, WS_MOD);
    for (int row = F.gw; row < MTOT; row += F.NGW) {
        const float* x = xin_row(F, row); const float* sh = md + (size_t)mod_of_row(row) * NMOD; const float* scl = sh + D; bf16* h = wsb(F, WS_H) + (size_t)row * D;
#pragma unroll
        for (int j = 0; j < 8; ++j) { const int c = 4 * (64 * j + F.lane); const f32x4 v = *(const f32x4*)(x + c), a = *(const f32x4*)(sh + c), s = *(const f32x4*)(scl + c);
            const f32x4 o = v * (s + 1.0f) + a; uint2 w; w.x = pk2(o[0], o[1]); w.y = pk2(o[2], o[3]); *(uint2*)(h + c) = w; }
    }
}
__device__ __forceinline__ void ln_phase(const Frame& F, const float* g, const float* b, const float* modl  , int shift_idx) {
    float* X = F.out;
    for (int row = F.gw; row < MTOT; row += F.NGW) {
        float* x = X + (size_t)row * D; f32x4 v[8]; float s = 0.f;
#pragma unroll
        for (int j = 0; j < 8; ++j) { v[j] = *(const f32x4*)(x + 4 * (64 * j + F.lane)); s += (v[j][0] + v[j][1]) + (v[j][2] + v[j][3]); }
        const float mean = wave_sum(s, F.lane) * (1.0f / D); float q = 0.f;
#pragma unroll
        for (int j = 0; j < 8; ++j) { v[j] = v[j] - mean; q += (v[j][0] * v[j][0] + v[j][1] * v[j][1]) + (v[j][2] * v[j][2] + v[j][3] * v[j][3]); }
        const float rstd = 1.0f / sqrtf(wave_sum(q, F.lane) * (1.0f / D) + LN_EPS);
        const float* sh = modl ? modl + (size_t)mod_of_row(row) * NMOD + (size_t)shift_idx * D : nullptr; bf16* h = wsb(F, WS_H) + (size_t)row * D;
#pragma unroll
        for (int j = 0; j < 8; ++j) { const int c = 4 * (64 * j + F.lane); const f32x4 o = v[j] * rstd * *(const f32x4*)(g + c) + *(const f32x4*)(b + c); *(f32x4*)(x + c) = o;
            if (sh) { const f32x4 hh = o * (*(const f32x4*)(sh + D + c) + 1.0f) + *(const f32x4*)(sh + c); uint2 w; w.x = pk2(hh[0], hh[1]); w.y = pk2(hh[2], hh[3]); *(uint2*)(h + c) = w; } }
    }
}
typedef short bf16x8 __attribute__((ext_vector_type(8)));
typedef short bf16x4 __attribute__((ext_vector_type(4)));
struct GlaArgs { const bf16* Gq; const bf16* Gk; const bf16* GvT; const float* Glr; const float* wa; const float* ba; const float* s0; float* Of; float* Ob; float* sfin; int L, nb; };
constexpr int GL_P = 272, GL_PT = 144;
constexpr int GL_QT = 0, GL_KT = 17408, GL_QE = 34816, GL_KD = 52224, GL_AT = 70656, GL_TOT = 79872, GL_DEC = 83968, GL_END = 84480;
__device__ __forceinline__ float log_sigmoid_f(float x) { return fminf(x, 0.f) - __logf(1.0f + __expf(-fabsf(x))); }
__device__ __forceinline__ void gla_unit(const Frame& F, const GlaArgs& A, int unit, int layer) {
    const int vs = unit & 1, dir = (unit >> 1) & 1, h = (unit >> 2) & 3, bl = unit >> 4;
    const int L = A.L, NC = L >> 6, lane = F.lane, w = F.wave, g = lane >> 4, r = lane & 15;
    LAS unsigned char* lds = F.lds;
    LAS float* tot = (LAS float*)(lds + GL_TOT); LAS float* dec = (LAS float*)(lds + GL_DEC);
    float wa0[16], wa1[16];
#pragma unroll
    for (int rr = 0; rr < 16; ++rr) { const float2 t = *(const float2*)(A.wa + ((size_t)dir * 16 + rr) * 512 + h * 128 + 2 * lane); wa0[rr] = t.x; wa1[rr] = t.y; }
    const float2 bav = *(const float2*)(A.ba + (size_t)dir * 512 + h * 128 + 2 * lane);
    f32x4 S[8];
    const int vcol = h * 256 + vs * 128 + w * 16 + r;
#pragma unroll
    for (int kt = 0; kt < 8; ++kt) {
        if (A.s0) { const float* sp = A.s0 + ((((size_t)bl * 2 + layer) * 2 + dir) * 4 + h) * (128 * 256) + (size_t)(16 * kt + 4 * g) * 256 + (vcol - h * 256);
            S[kt] = (f32x4){sp[0], sp[256], sp[512], sp[768]}; }
        else S[kt] = (f32x4){0.f, 0.f, 0.f, 0.f};
    }
    float* Od = dir ? A.Ob : A.Of;
    for (int cn = 0; cn < NC; ++cn) {
        const int n = dir ? NC - 1 - cn : cn; const size_t rl0 = (size_t)bl * L + 64 * n;
        const bf16* vp = A.GvT + ((size_t)bl * 1024 + vcol) * L + 64 * n + 8 * g;
        const bf16x8 vf0 = *(const bf16x8*)vp, vf1 = *(const bf16x8*)(vp + 32);
        float la0[8], la1[8]; unsigned qv[8], kv[8];
#pragma unroll
        for (int i = 0; i < 8; ++i) { const size_t row = rl0 + 8 * w + i; const float* lr = A.Glr + row * 32 + dir * 16;
            float x0 = bav.x, x1 = bav.y;
#pragma unroll
            for (int rr = 0; rr < 16; ++rr) { const float lv = lr[rr]; x0 += lv * wa0[rr]; x1 += lv * wa1[rr]; }
            la0[i] = log_sigmoid_f(x0) * 0.0625f; la1[i] = log_sigmoid_f(x1) * 0.0625f;
            qv[i] = *(const unsigned*)(A.Gq + row * 512 + h * 128 + 2 * lane); kv[i] = *(const unsigned*)(A.Gk + row * 512 + h * 128 + 2 * lane); }
        if (!dir) {
#pragma unroll
            for (int i = 1; i < 8; ++i) { la0[i] += la0[i - 1]; la1[i] += la1[i - 1]; }
            tot[w * 128 + 2 * lane] = la0[7]; tot[w * 128 + 2 * lane + 1] = la1[7];
        } else {
#pragma unroll
            for (int i = 6; i >= 0; --i) { la0[i] += la0[i + 1]; la1[i] += la1[i + 1]; }
            tot[w * 128 + 2 * lane] = la0[0]; tot[w * 128 + 2 * lane + 1] = la1[0];
        }
        __syncthreads();
        float off0 = 0.f, off1 = 0.f, all0 = 0.f, all1 = 0.f;
#pragma unroll
        for (int ww = 0; ww < 8; ++ww) { const float t0 = tot[ww * 128 + 2 * lane], t1 = tot[ww * 128 + 2 * lane + 1]; all0 += t0; all1 += t1;
            const bool before = dir ? (ww > w) : (ww < w); if (before) { off0 += t0; off1 += t1; } }
        const float ref0 = 0.5f * all0, ref1 = 0.5f * all1;
        if (w == 0) { dec[2 * lane] = __expf(all0); dec[2 * lane + 1] = __expf(all1); }
        unsigned kd0[4], kd1[4];
#pragma unroll
        for (int i = 0; i < 8; ++i) { const float b0 = la0[i] + off0, b1 = la1[i] + off1;
            const float q0 = __uint_as_float(qv[i] << 16), q1 = __uint_as_float(qv[i] & 0xffff0000u), k0 = __uint_as_float(kv[i] << 16), k1 = __uint_as_float(kv[i] & 0xffff0000u);
            const int ti = 8 * w + i;
            *(LAS unsigned*)(lds + GL_QT + ti * GL_P + 4 * lane) = pk2(q0 * __expf(b0 - ref0), q1 * __expf(b1 - ref1));
            *(LAS unsigned*)(lds + GL_KT + ti * GL_P + 4 * lane) = pk2(k0 * __expf(ref0 - b0), k1 * __expf(ref1 - b1));
            *(LAS unsigned*)(lds + GL_QE + ti * GL_P + 4 * lane) = pk2(q0 * __expf(b0), q1 * __expf(b1));
            const unsigned short e0 = (unsigned short)f2bf(k0 * __expf(all0 - b0)), e1 = (unsigned short)f2bf(k1 * __expf(all1 - b1));
            if (i & 1) { kd0[i >> 1] |= (unsigned)e0 << 16; kd1[i >> 1] |= (unsigned)e1 << 16; } else { kd0[i >> 1] = e0; kd1[i >> 1] = e1; } }
        *(LAS v4u*)(lds + GL_KD + (2 * lane) * GL_PT + 16 * w) = (v4u){kd0[0], kd0[1], kd0[2], kd0[3]};
        *(LAS v4u*)(lds + GL_KD + (2 * lane + 1) * GL_PT + 16 * w) = (v4u){kd1[0], kd1[1], kd1[2], kd1[3]};
        __syncthreads();
        { const int it = w & 3;
#pragma unroll
          for (int ss = 0; ss < 2; ++ss) { const int st = 2 * (w >> 2) + ss; f32x4 c = {0.f, 0.f, 0.f, 0.f};
#pragma unroll
              for (int ks = 0; ks < 4; ++ks) { const bf16x8 a = *(const LAS bf16x8*)(lds + GL_KT + (16 * st + r) * GL_P + 64 * ks + 16 * g);
                  const bf16x8 b = *(const LAS bf16x8*)(lds + GL_QT + (16 * it + r) * GL_P + 64 * ks + 16 * g);
                  c = __builtin_amdgcn_mfma_f32_16x16x32_bf16(a, b, c, 0, 0, 0); }
              const int ig = 16 * it + r, s0 = 16 * st + 4 * g;
#pragma unroll
              for (int q = 0; q < 4; ++q) { const bool keep = dir ? (s0 + q >= ig) : (s0 + q <= ig); if (!keep) c[q] = 0.f; }
              *(LAS u32x2*)(lds + GL_AT + ig * GL_PT + 2 * s0) = (u32x2){pk2(c[0], c[1]), pk2(c[2], c[3])}; } }
        __syncthreads();
        bf16x8 sb[4];
#pragma unroll
        for (int kk = 0; kk < 4; ++kk) { const unsigned p0 = pk2(S[2 * kk][0], S[2 * kk][1]), p1 = pk2(S[2 * kk][2], S[2 * kk][3]), p2 = pk2(S[2 * kk + 1][0], S[2 * kk + 1][1]), p3 = pk2(S[2 * kk + 1][2], S[2 * kk + 1][3]);
            sb[kk] = __builtin_bit_cast(bf16x8, (v4u){p0, p1, p2, p3}); }
#pragma unroll
        for (int it = 0; it < 4; ++it) { f32x4 o = {0.f, 0.f, 0.f, 0.f}; const int i = 16 * it + r;
            { const bf16x8 a0 = *(const LAS bf16x8*)(lds + GL_AT + i * GL_PT + 16 * g), a1 = *(const LAS bf16x8*)(lds + GL_AT + i * GL_PT + 64 + 16 * g);
              o = __builtin_amdgcn_mfma_f32_16x16x32_bf16(a0, vf0, o, 0, 0, 0); o = __builtin_amdgcn_mfma_f32_16x16x32_bf16(a1, vf1, o, 0, 0, 0); }
#pragma unroll
            for (int kk = 0; kk < 4; ++kk) { const u32x2 lo = *(const LAS u32x2*)(lds + GL_QE + i * GL_P + 64 * kk + 8 * g), hi = *(const LAS u32x2*)(lds + GL_QE + i * GL_P + 64 * kk + 32 + 8 * g);
                const bf16x8 a = __builtin_bit_cast(bf16x8, (v4u){lo.x, lo.y, hi.x, hi.y});
                o = __builtin_amdgcn_mfma_f32_16x16x32_bf16(a, sb[kk], o, 0, 0, 0); }
            float* op = Od + (rl0 + 16 * it + 4 * g) * 1024 + vcol;
            op[0] = o[0]; op[1024] = o[1]; op[2048] = o[2]; op[3072] = o[3]; }
#pragma unroll
        for (int kt = 0; kt < 8; ++kt) { const f32x4 dv = *(const LAS f32x4*)(dec + 16 * kt + 4 * g); f32x4 c = S[kt] * dv; const int k = 16 * kt + r;
            const bf16x8 a0 = *(const LAS bf16x8*)(lds + GL_KD + k * GL_PT + 16 * g), a1 = *(const LAS bf16x8*)(lds + GL_KD + k * GL_PT + 64 + 16 * g);
            c = __builtin_amdgcn_mfma_f32_16x16x32_bf16(a0, vf0, c, 0, 0, 0); c = __builtin_amdgcn_mfma_f32_16x16x32_bf16(a1, vf1, c, 0, 0, 0); S[kt] = c; }
        __syncthreads();
    }
    if (A.sfin) {
#pragma unroll
        for (int kt = 0; kt < 8; ++kt) { float* sp = A.sfin + ((((size_t)bl * 2 + layer) * 2 + dir) * 4 + h) * (128 * 256) + (size_t)(16 * kt + 4 * g) * 256 + (vcol - h * 256);
            sp[0] = S[kt][0]; sp[256] = S[kt][1]; sp[512] = S[kt][2]; sp[768] = S[kt][3]; }
    }
}
typedef float f32x16 __attribute__((ext_vector_type(16)));
struct AttnArgs { const bf16* Dq; const bf16* Dk; const bf16* DvT; const bf16* Ck; const bf16* CvT; bf16* Yc; const float* ng; const float* lamp; int layer; int L, nbatch, nqb; };
constexpr int AT_KP = 144, AT_VP = 136, AT_KB = 64 * AT_KP  , AT_VB = 128 * AT_VP  , AT_STAGE = AT_KB + AT_VB;
__device__ __forceinline__ void attn_pass(const Frame& F, const AttnArgs& A, const int j, const int bl, const int h, const size_t qrow, f32x16 (&O)[4], float& lsum) {
    const int L = A.L, lane = F.lane, tid = F.tid, c = lane & 31, h2 = lane >> 5;
    LAS unsigned char* lds = F.lds;
    const int nct = A.Ck ? 4 : 0, ntile = nct + (L >> 6);
    const int kkey = tid >> 3, kpart = tid & 7, vdv0 = tid >> 3, vpart = tid & 7;
    const unsigned koff = (unsigned)(kkey * 1024 + kpart * 8), voff = (unsigned)vdv0 * (unsigned)L + vpart * 8, voffc = (unsigned)(vdv0 * 256 + vpart * 8);
#define AT_ISSUE(t_) do { const int t__ = (t_); \
        if (t__ < nct) { const bf16* kb_ = A.Ck + ((size_t)bl * 256 + 64 * t__) * 1024 + h * 128 + 64 * j; pk0 = *(const v4u*)(kb_ + koff); \
            const bf16* vb_ = A.CvT + ((size_t)bl * 1024 + h * 128) * 256 + 64 * t__; pv0 = *(const v4u*)(vb_ + voffc); pv1 = *(const v4u*)(vb_ + voffc + 64 * 256); } \
        else { const int k0_ = 64 * (t__ - nct); const bf16* kb_ = A.Dk + ((size_t)bl * L + k0_) * 1024 + h * 128 + 64 * j; pk0 = *(const v4u*)(kb_ + koff); \
            const bf16* vb_ = A.DvT + ((size_t)bl * 1024 + h * 128) * L + k0_; pv0 = *(const v4u*)(vb_ + voff); pv1 = *(const v4u*)(vb_ + voff + 64u * (unsigned)L); } } while (0)
#define AT_COMMIT(buf_) do { LAS unsigned char* kb_ = lds + (buf_) * AT_STAGE; LAS unsigned char* vb_ = kb_ + AT_KB; \
        *(LAS v4u*)(kb_ + kkey * AT_KP + kpart * 16) = pk0; \
        *(LAS u32x2*)(vb_ + vdv0 * AT_VP + vpart * 16) = (u32x2){pv0.x, pv0.y}; *(LAS u32x2*)(vb_ + vdv0 * AT_VP + vpart * 16 + 8) = (u32x2){pv0.z, pv0.w}; \
        *(LAS u32x2*)(vb_ + (vdv0 + 64) * AT_VP + vpart * 16) = (u32x2){pv1.x, pv1.y}; *(LAS u32x2*)(vb_ + (vdv0 + 64) * AT_VP + vpart * 16 + 8) = (u32x2){pv1.z, pv1.w}; } while (0)
    v4u pk0, pv0, pv1;
    bf16x8 qf[4];
#pragma unroll
    for (int ks = 0; ks < 4; ++ks) qf[ks] = *(const bf16x8*)(A.Dq + qrow * 1024 + h * 128 + 64 * j + 16 * ks + 8 * h2);
#pragma unroll
    for (int d = 0; d < 4; ++d)
#pragma unroll
        for (int e = 0; e < 16; ++e) O[d][e] = 0.f;
    float mj = -1e30f, lj = 0.f;
    AT_ISSUE(0); AT_COMMIT(0); __syncthreads();
#pragma unroll 1
    for (int t = 0; t < ntile; ++t) {
        const int buf = t & 1;
        if (t + 1 < ntile) AT_ISSUE(t + 1);
        const LAS unsigned char* kb = lds + buf * AT_STAGE; const LAS unsigned char* vb = kb + AT_KB;
        f32x16 s[2];
#pragma unroll
        for (int kt = 0; kt < 2; ++kt) {
#pragma unroll
            for (int e = 0; e < 16; ++e) s[kt][e] = 0.f;
#pragma unroll
            for (int ks = 0; ks < 4; ++ks) { const bf16x8 a = *(const LAS bf16x8*)(kb + (32 * kt + c) * AT_KP + (16 * ks + 8 * h2) * 2);
                s[kt] = __builtin_amdgcn_mfma_f32_32x32x16_bf16(a, qf[ks], s[kt], 0, 0, 0); } }
        float mx = s[0][0];
#pragma unroll
        for (int e = 1; e < 16; ++e) mx = fmaxf(mx, s[0][e]);
#pragma unroll
        for (int e = 0; e < 16; ++e) mx = fmaxf(mx, s[1][e]);
        mx = fmaxf(mx, shflx(mx, 32, lane));
        const float mnew = fmaxf(mj, mx), alpha = __builtin_amdgcn_exp2f(mj - mnew); mj = mnew;
        float ls = 0.f;
#pragma unroll
        for (int kt = 0; kt < 2; ++kt)
#pragma unroll
            for (int e = 0; e < 16; ++e) { const float p = __builtin_amdgcn_exp2f(s[kt][e] - mnew); s[kt][e] = p; ls += p; }
        lj = lj * alpha + ls;
#pragma unroll
        for (int d = 0; d < 4; ++d)
#pragma unroll
            for (int e = 0; e < 16; ++e) O[d][e] *= alpha;
#pragma unroll
        for (int kt = 0; kt < 2; ++kt)
#pragma unroll
            for (int sp = 0; sp < 2; ++sp) {
                const bf16x8 pf = __builtin_bit_cast(bf16x8, (v4u){pk2(s[kt][8 * sp + 0], s[kt][8 * sp + 1]), pk2(s[kt][8 * sp + 2], s[kt][8 * sp + 3]), pk2(s[kt][8 * sp + 4], s[kt][8 * sp + 5]), pk2(s[kt][8 * sp + 6], s[kt][8 * sp + 7])});
#pragma unroll
                for (int d = 0; d < 4; ++d) { const LAS unsigned char* vp = vb + (32 * d + c) * AT_VP + (32 * kt + 16 * sp + 4 * h2) * 2;
                    const u32x2 lo = *(const LAS u32x2*)vp, hi = *(const LAS u32x2*)(vp + 16);
                    const bf16x8 a = __builtin_bit_cast(bf16x8, (v4u){lo.x, lo.y, hi.x, hi.y});
                    O[d] = __builtin_amdgcn_mfma_f32_32x32x16_bf16(a, pf, O[d], 0, 0, 0); } }
        if (t + 1 < ntile) AT_COMMIT(buf ^ 1);
        __syncthreads();
    }
    lsum = lj;
#undef AT_ISSUE
#undef AT_COMMIT
}
__device__ __forceinline__ void attn_unit(const Frame& F, const AttnArgs& A, int unit) {
    const int qb = unit % A.nqb, h = (unit / A.nqb) & 7, bl = unit / (A.nqb * 8);
    const int lane = F.lane, c = lane & 31, h2 = lane >> 5;
    const size_t qrow = (size_t)bl * A.L + 256 * qb + 32 * F.wave + c;
    unsigned Op[4][8];
    { f32x16 O[4]; float l0; attn_pass(F, A, 0, bl, h, qrow, O, l0);
      const float i0 = 1.0f / (l0 + shflx(l0, 32, lane));
#pragma unroll
      for (int d = 0; d < 4; ++d)
#pragma unroll
          for (int e = 0; e < 8; ++e) Op[d][e] = pk2(O[d][2 * e] * i0, O[d][2 * e + 1] * i0); }
    f32x16 O[4]; float l1; attn_pass(F, A, 1, bl, h, qrow, O, l1);
    float lam;
    { const float* lp = A.lamp; float d01 = 0.f, d23 = 0.f;
      for (int i = 0; i < 64; ++i) { d01 += lp[i] * lp[64 + i]; d23 += lp[128 + i] * lp[192 + i]; }
      lam = expf(d01) - expf(d23); }
    int lyr = A.layer; asm volatile("" : "+s"(lyr));
    const float lam_init = lyr == 0 ? 0.2f : 0.8f - 0.6f * 0.7408182206817179f; lam += lam_init;
    const float i1 = lam / (l1 + shflx(l1, 32, lane)); float ss = 0.f;
#pragma unroll
    for (int d = 0; d < 4; ++d)
#pragma unroll
        for (int e = 0; e < 8; ++e) { const float a0 = __uint_as_float(Op[d][e] << 16) - O[d][2 * e] * i1, a1 = __uint_as_float(Op[d][e] & 0xffff0000u) - O[d][2 * e + 1] * i1;
            O[d][2 * e] = a0; O[d][2 * e + 1] = a1; ss += a0 * a0 + a1 * a1; }
    ss += shflx(ss, 32, lane);
    const float rn = (1.0f - lam_init) / sqrtf(ss * (1.0f / 128.0f) + RMS_EPS);
    bf16* yo = A.Yc + qrow * 1024 + h * 128;
#pragma unroll
    for (int d = 0; d < 4; ++d)
#pragma unroll
        for (int rg = 0; rg < 4; ++rg) { const int dv = 32 * d + 8 * rg + 4 * h2; const f32x4 gg = *(const f32x4*)(A.ng + dv);
            u32x2 o; o.x = pk2(O[d][4 * rg + 0] * rn * gg[0], O[d][4 * rg + 1] * rn * gg[1]); o.y = pk2(O[d][4 * rg + 2] * rn * gg[2], O[d][4 * rg + 3] * rn * gg[3]);
            *(u32x2*)(yo + dv) = o; }
}
#ifndef FFT_HOST
typedef float cfl __attribute__((ext_vector_type(2)));
#define FFT_C cfl
#define FFT_MK(a, b) ((cfl){(a), (b)})
#define FFT_PTR LAS cfl*
#define FFT_DEV __device__ __forceinline__
#define FFT_MDEV static __device__ __forceinline__
#else
#define FFT_C float2
#define FFT_MK(a, b) make_float2((a), (b))
#define FFT_PTR FFT_C*
#define FFT_DEV static inline
#define FFT_MDEV static inline
#endif
FFT_DEV int fpad(int p) { return p + (p >> 3); }
FFT_DEV FFT_C cmul(FFT_C a, FFT_C b) { return FFT_MK(a.x * b.x - a.y * b.y, a.x * b.y + a.y * b.x); }
template <int M16> FFT_DEV FFT_C mul_w16(FFT_C d) {
    constexpr float C1 = 0.92387953251128674f, S1 = 0.38268343236508977f, H = 0.70710678118654752f;
    if (M16 == 0) return d;
    if (M16 == 4) return FFT_MK(d.y, -d.x);
    constexpr float wr = M16 == 1 ? C1 : M16 == 2 ? H : M16 == 3 ? S1 : M16 == 5 ? -S1 : M16 == 6 ? -H : -C1;
    constexpr float wi = M16 == 1 ? -S1 : M16 == 2 ? -H : M16 == 3 ? -C1 : M16 == 5 ? -C1 : M16 == 6 ? -H : -S1;
    return FFT_MK(d.x * wr - d.y * wi, d.x * wi + d.y * wr);
}
template <int R, int HALF, int G0, int T> struct DifStep {
    FFT_MDEV void run(FFT_C (&x)[R]) {
        const FFT_C a = x[G0 + T], b = x[G0 + T + HALF];
        x[G0 + T] = FFT_MK(a.x + b.x, a.y + b.y);
        x[G0 + T + HALF] = mul_w16<(T * 8) / HALF>(FFT_MK(a.x - b.x, a.y - b.y));
        if constexpr (T + 1 < HALF) DifStep<R, HALF, G0, T + 1>::run(x);
        else if constexpr (G0 + 2 * HALF < R) DifStep<R, HALF, G0 + 2 * HALF, 0>::run(x);
        else if constexpr (HALF > 1) DifStep<R, HALF / 2, 0, 0>::run(x);
    }
};
template <int R> FFT_DEV void dft_fwd(FFT_C (&x)[R]) { DifStep<R, R / 2, 0, 0>::run(x); }
template <int R> FFT_DEV constexpr int brev(int i) { int r = 0; for (int b = 1; b < R; b <<= 1) { r = (r << 1) | (i & 1); i >>= 1; } return r; }
template <int R, int Q, int K1> struct StoreFwd {
    FFT_MDEV void run(FFT_PTR buf, int base, const FFT_C (&x)[R], FFT_C w, FFT_C w1) {
        constexpr int i = brev<R>(K1);
        buf[fpad(base + K1 * Q)] = (Q > 1 && K1 > 0) ? cmul(x[i], w) : x[i];
        if constexpr (K1 + 1 < R) StoreFwd<R, Q, K1 + 1>::run(buf, base, x, Q > 1 ? cmul(w, w1) : w, w1);
    }
};
template <int R, int Q, int K> struct TwInv {
    FFT_MDEV void run(FFT_C (&x)[R], FFT_C w, FFT_C w1) {
        const FFT_C c = FFT_MK(x[K].x, -x[K].y); x[K] = (Q > 1 && K > 0) ? cmul(c, w) : c;
        if constexpr (K + 1 < R) TwInv<R, Q, K + 1>::run(x, Q > 1 ? cmul(w, w1) : w, w1);
    }
};
template <int R, int Q, int I> struct StoreInv {
    FFT_MDEV void run(FFT_PTR buf, int base, const FFT_C (&x)[R]) {
        constexpr int j = brev<R>(I);
        buf[fpad(base + j * Q)] = FFT_MK(x[I].x, -x[I].y);
        if constexpr (I + 1 < R) StoreInv<R, Q, I + 1>::run(buf, base, x);
    }
};
template <int R, int J> struct LoadX {
    FFT_MDEV void run(FFT_PTR buf, int base, int q, FFT_C (&x)[R]) { x[J] = buf[fpad(base + J * q)]; if constexpr (J + 1 < R) LoadX<R, J + 1>::run(buf, base, q, x); }
};
template <int R, int NSUB, bool INV> FFT_DEV void fft_pass(FFT_PTR buf, const FFT_C* tw, int tid) {
    constexpr int q = NSUB / R, NB = 8192 / R, PER = NB / 512;
#pragma unroll 1
    for (int u = 0; u < PER; ++u) {
        const int beta = tid + u * 512, blk = beta / q, np = beta % q, base = blk * NSUB + np;
        FFT_C x[R];
        LoadX<R, 0>::run(buf, base, q, x);
        FFT_C w1 = FFT_MK(1.f, 0.f);
        if (q > 1) w1 = tw[np * (8192 / NSUB)];
        if (!INV) { dft_fwd<R>(x); StoreFwd<R, q, 0>::run(buf, base, x, FFT_MK(1.f, 0.f), w1); }
        else { TwInv<R, q, 0>::run(x, FFT_MK(1.f, 0.f), w1); dft_fwd<R>(x); StoreInv<R, q, 0>::run(buf, base, x); }
    }
}
constexpr int FFT_BUFB = 73728;
struct HyArgs { const bf16* ZhT; bf16* YaT; const float* filt; const float* cw; const float* cb; const float* hbias; const cfl* tw; int L, nb; };
#define FFT_FWD_BOTH(A_, B_, tw_, tid_) do { fft_pass<16, 8192, false>(A_, tw_, tid_); fft_pass<16, 8192, false>(B_, tw_, tid_); __syncthreads(); \
    fft_pass<8, 512, false>(A_, tw_, tid_); fft_pass<8, 512, false>(B_, tw_, tid_); __syncthreads(); \
    fft_pass<8, 64, false>(A_, tw_, tid_); fft_pass<8, 64, false>(B_, tw_, tid_); __syncthreads(); \
    fft_pass<8, 8, false>(A_, tw_, tid_); fft_pass<8, 8, false>(B_, tw_, tid_); __syncthreads(); } while (0)
#define FFT_INV(A_, tw_, tid_) do { fft_pass<8, 8, true>(A_, tw_, tid_); __syncthreads(); fft_pass<8, 64, true>(A_, tw_, tid_); __syncthreads(); \
    fft_pass<8, 512, true>(A_, tw_, tid_); __syncthreads(); fft_pass<16, 8192, true>(A_, tw_, tid_); __syncthreads(); } while (0)
__device__ __forceinline__ float shortconv(const bf16* zrow, int t, int L, float w0, float w1, float w2, float b) {
    const float zm = t > 0 ? bf2f(zrow[t - 1]) : 0.f, z0 = bf2f(zrow[t]), zp = t + 1 < L ? bf2f(zrow[t + 1]) : 0.f;
    return w0 * zm + w1 * z0 + w2 * zp + b;
}
__device__ __forceinline__ void hyena_lat_unit(const Frame& F, const HyArgs& A, int c, cfl* zsc) {
    constexpr int L = 4096; const int tid = F.tid;
    LAS cfl* bA = (LAS cfl*)(F.lds); LAS cfl* bB = (LAS cfl*)(F.lds + FFT_BUFB);
    const bf16* z0 = A.ZhT + (size_t)c * L; const bf16* z1 = A.ZhT + ((size_t)3072 + c) * L;
    { const float w0 = A.cw[c], w1 = A.cw[3072 + c], w2 = A.cw[6144 + c], b = A.cb[c];
#pragma unroll 2
      for (int i = 0; i < 8; ++i) { const int t = tid + 512 * i; bA[fpad(t)] = FFT_MK(shortconv(z0, t, L, w0, w1, w2, b), shortconv(z1, t, L, w0, w1, w2, b)); bA[fpad(t + L)] = FFT_MK(0.f, 0.f); } }
#pragma unroll 1
    for (int ord = 0; ord < 2; ++ord) {
        const float* hf = A.filt + ((size_t)(ord * 2 + 0) * 1024 + c) * L; const float* hb = A.filt + ((size_t)(ord * 2 + 1) * 1024 + c) * L;
#pragma unroll 2
        for (int i = 0; i < 8; ++i) { const int j = tid + 512 * i;
            bB[fpad(j)] = FFT_MK(hf[j], 0.f);
            if (j > 0) bB[fpad(2 * L - j)] = FFT_MK(hb[j], 0.f); else bB[fpad(L)] = FFT_MK(0.f, 0.f); }
        __syncthreads();
        FFT_FWD_BOTH(bA, bB, A.tw, tid);
#pragma unroll 4
        for (int i = 0; i < 16; ++i) { const int p = fpad(tid + 512 * i); bA[p] = cmul(bA[p], bB[p]); }
        __syncthreads();
        FFT_INV(bA, A.tw, tid);
        const float bias = A.hbias[ord * 1024 + c]; const int col = (ord + 1) * 1024 + c;
        const float w0 = A.cw[col], w1 = A.cw[3072 + col], w2 = A.cw[6144 + col], b = A.cb[col];
        const float v0 = A.cw[c], v1 = A.cw[3072 + c], v2 = A.cw[6144 + c], vb = A.cb[c];
#pragma unroll 2
        for (int i = 0; i < 8; ++i) { const int t = tid + 512 * i; const cfl y = bA[fpad(t)];
            const cfl in = ord == 0 ? FFT_MK(shortconv(z0, t, L, v0, v1, v2, vb), shortconv(z1, t, L, v0, v1, v2, vb)) : zsc[t];
            const float g0 = shortconv(z0 + (size_t)(ord + 1) * 1024 * L, t, L, w0, w1, w2, b), g1 = shortconv(z1 + (size_t)(ord + 1) * 1024 * L, t, L, w0, w1, w2, b);
            const cfl o = FFT_MK(g0 * (y.x * (1.0f / 8192.0f) + in.x * bias), g1 * (y.y * (1.0f / 8192.0f) + in.y * bias));
            if (ord == 0) { zsc[t] = o; bA[fpad(t)] = o; bA[fpad(t + L)] = FFT_MK(0.f, 0.f); }
            else { A.YaT[(size_t)c * L + t] = f2b(o.x); A.YaT[((size_t)1024 + c) * L + t] = f2b(o.y); } }
        __syncthreads();
    }
}
__device__ __forceinline__ void hyena_ctx_unit(const Frame& F, const HyArgs& A, int unit) {
    constexpr int L = 256; const int tid = F.tid, t = tid & 255, hs = tid >> 8, b = unit >> 9, c = (unit & 511) * 2 + hs;
    LAS float* sv = (LAS float*)(F.lds) + hs * 256;
    LAS float* sf = (LAS float*)(F.lds + 2048) + hs * 512;
    float cw[3][3], cbv[3];
#pragma unroll
    for (int s = 0; s < 3; ++s) { const int col = s * 1024 + c; cbv[s] = A.cb[col];
#pragma unroll
        for (int k = 0; k < 3; ++k) cw[s][k] = A.cw[k * 3072 + col]; }
    const bf16* z0 = A.ZhT + ((size_t)b * 3072 + c) * L;
    float in = shortconv(z0, t, L, cw[0][0], cw[0][1], cw[0][2], cbv[0]);
#pragma unroll
    for (int ord = 0; ord < 2; ++ord) {
        sv[t] = in; sf[t] = A.filt[((size_t)(ord * 2 + 0) * 1024 + c) * L + t]; sf[256 + t] = A.filt[((size_t)(ord * 2 + 1) * 1024 + c) * L + t];
        __syncthreads();
        float y = 0.f;
        for (int s = 0; s <= t; ++s) y += sf[t - s] * sv[s];
        for (int s = t + 1; s < L; ++s) y += sf[256 + s - t] * sv[s];
        const float g = shortconv(z0 + (size_t)(ord + 1) * 1024 * L, t, L, cw[ord + 1][0], cw[ord + 1][1], cw[ord + 1][2], cbv[ord + 1]);
        in = g * (y + in * A.hbias[ord * 1024 + c]);
        __syncthreads();
    }
    A.YaT[((size_t)b * 1024 + c) * L + t] = f2b(in);
}
__device__ __forceinline__ void filt_item(const Frame& F, int layer, int item) {
    const int ls = item < 1024 ? 1 : 0, r = ls ? item : item - 1024, cb = ls ? (r >> 4) : r, jb = ls ? (r & 15) : 0, L = ls ? 4096 : 256;
    LAS float* sh = (LAS float*)(F.lds);
    LAS float* sw = (LAS float*)(F.lds + 256 * 65 * 4);
    const float* hd = wsf(F, WS_HDN) + (((size_t)layer * 2 + ls) * 4096 + jb * 256) * FH;
    for (int i = F.tid; i < 256 * 64; i += 512) sh[(i >> 6) * 65 + (i & 63)] = hd[i];
    const float* w3 = F.in[I_HW3] + (size_t)layer * FH * 4096 + cb * 64;
    for (int i = F.tid; i < 64 * 64; i += 512) sw[i] = w3[(size_t)(i >> 6) * 4096 + (i & 63)];
    __syncthreads();
    const int j = F.tid & 255, c0 = (F.tid >> 8) * 32; float acc[32];
#pragma unroll
    for (int q = 0; q < 32; ++q) acc[q] = 0.f;
    for (int m = 0; m < 64; ++m) { const float hv = sh[j * 65 + m];
#pragma unroll
        for (int q = 0; q < 32; ++q) acc[q] += hv * sw[m * 64 + c0 + q]; }
    const float tj = (float)(jb * 256 + j) / (float)(L - 1);
    float* out = wsf(F, WS_FILT) + (ls ? 0 : (size_t)4 * 1024 * 4096);
#pragma unroll
    for (int q = 0; q < 32; ++q) { const int col = cb * 64 + c0 + q; const float dc = fabsf(F.in[I_HDEC][(size_t)layer * 4096 + col]);
        out[(size_t)col * L + jb * 256 + j] = acc[q] * __expf(-tj * dc); }
    __syncthreads();
}
struct FinArgs { const float* Of; const float* Ob; const bf16* Gr; const float* gn; bf16* Yb; const bf16* YaT; bf16* Ya; int nr, L, lshift; };
__device__ __forceinline__ void fin_phase(const Frame& F, const FinArgs& A) {
    for (int row = F.gw; row < A.nr; row += F.NGW) {
#pragma unroll
        for (int hh = 0; hh < 4; ++hh) { const size_t o = (size_t)row * 1024 + hh * 256 + 4 * F.lane; const f32x4 v = *(const f32x4*)(A.Of + o) + *(const f32x4*)(A.Ob + o);
            const float ss = wave_sum((v[0] * v[0] + v[1] * v[1]) + (v[2] * v[2] + v[3] * v[3]), F.lane); const float rn = 1.0f / sqrtf(ss * (1.0f / 256.0f) + RMS_EPS);
            const f32x4 g = *(const f32x4*)(A.gn + 4 * F.lane); const u32x2 gr = *(const u32x2*)(A.Gr + o);
            const float r0 = __uint_as_float(gr.x << 16), r1 = __uint_as_float(gr.x & 0xffff0000u), r2 = __uint_as_float(gr.y << 16), r3 = __uint_as_float(gr.y & 0xffff0000u);
            u32x2 w; w.x = pk2(v[0] * rn * g[0] * r0, v[1] * rn * g[1] * r1); w.y = pk2(v[2] * rn * g[2] * r2, v[3] * rn * g[3] * r3); *(u32x2*)(A.Yb + o) = w; }
    }
    LAS bf16* sc = (LAS bf16*)(F.lds + F.wave * 16384);
    const int nit = (A.nr >> 6) * 16;
    for (int it = F.gw; it < nit; it += F.NGW) { const int rb = it >> 4, cb = it & 15, r0 = rb * 64, b = r0 >> A.lshift, t0 = r0 & (A.L - 1);
        for (int cc = 0; cc < 64; ++cc) sc[cc * 66 + F.lane] = A.YaT[((size_t)b * 1024 + cb * 64 + cc) * A.L + t0 + F.lane];
        LDS_WAIT(); asm volatile("" ::: "memory");
        for (int rr = 0; rr < 64; ++rr) A.Ya[(size_t)(r0 + rr) * 1024 + cb * 64 + F.lane] = sc[F.lane * 66 + rr];
        LDS_WAIT(); asm volatile("" ::: "memory"); }
}
struct Chunk { int r0, nr, L, lshift, nb, b0; bool lat; };
__device__ __forceinline__ Chunk chunk_of(int ch) { Chunk c; if (ch == 0) { c.r0 = 0; c.nr = RCTX; c.L = LCTX; c.lshift = 8; c.nb = NCTXB; c.b0 = 0; c.lat = false; }
    else { c.r0 = RCTX + (ch - 1) * 8192; c.nr = 8192; c.L = LLAT; c.lshift = 12; c.nb = 2; c.b0 = 2 * (ch - 1); c.lat = true; } return c; }
constexpr int CW_QUEUE = 1024;
__device__ __forceinline__ void grid_bar() {
    const Frame F = make_frame();
    XcdBarrier b; b.bar = (unsigned*)(F.ctl + CW_BAR); b.x = xb_xcc_id(); b.st = F.MISC + 8;
    xcd_barrier(b);
}
#define GRID_BAR() grid_bar()

__global__ void __launch_bounds__(NWAVES * 64, 2) fwd_kernel(Args args) {
    {   const Frame F = make_frame();
        for (int u = F.tid; u < (LDS_BYTES - LDSCTL_OFF) / 4; u += NWAVES * 64) ((LAS unsigned*)(F.lds + LDSCTL_OFF))[u] = 0u;
        __syncthreads();
        (void)xcd_barrier_post((unsigned*)(F.ctl + CW_BAR), F.MISC + 8);
        p0_prologue(F); }
    GRID_BAR();
    {   const Frame F = make_frame(); p0_h0(F);
        for (int it = blockIdx.x; it < 1088; it += F.G) filt_item(F, 0, it); }
    GRID_BAR();

#pragma unroll 1
    for (int l = 0; l < DEPTH; ++l) {
        if (l == 1) { const Frame F = make_frame(); for (int it = blockIdx.x; it < 1088; it += F.G) filt_item(F, 1, it); }
#pragma unroll 1
        for (int s = 0; s < 3; ++s) {
            if (s != 1) {
                const int fi = s >> 1;
                { const Frame F = make_frame(); unsigned char* wl = F.ws + WS_W + (size_t)l * WL_STRIDE;
                  pg8::Gemm g{(const pg8::bf16_t*)wsb(F, WS_H), (const pg8::bf16_t*)(wl + WL_W13) + (size_t)fi * 11008 * D, MTOT, 11008, D};
                  pg8::StaticOrder S; S.init(MTOT, 11008, F.G, (int)blockIdx.x);
                  pg8::EpiSwiglu E{(pg8::bf16_t*)wsb(F, WS_U), FF};
                  pg8::gemm_phase<pg8::EpiSwiglu, pg8::StaticOrder, true, true>(F.lds + RING_OFF, g, S, E); }
                GRID_BAR();
                { const Frame F = make_frame(); unsigned char* wl = F.ws + WS_W + (size_t)l * WL_STRIDE; float* X = F.out;
                  const float* modl = wsf(F, WS_MOD) + (size_t)l * 9 * NMOD;
                  pg8::Gemm g{(const pg8::bf16_t*)wsb(F, WS_U), (const pg8::bf16_t*)(wl + WL_W2) + (size_t)fi * D * FF, MTOT, D, FF};
                  pg8::StaticOrder S; S.init(MTOT, D, F.G, (int)blockIdx.x);
                  const bool first = (l == 0 && s == 0);
                  pg8::EpiResid E{first ? F.in[I_XP] : X, first ? F.in[I_XS] : X + (size_t)RCTX * D, X, modl + (size_t)(s == 0 ? 2 : 8) * D, 0, 0.5f};
                  pg8::gemm_phase<pg8::EpiResid, pg8::StaticOrder, true, true>(F.lds + RING_OFF, g, S, E); }
                GRID_BAR();
            } else {
#pragma unroll 1
                for (int ch = 0; ch < NCHUNK; ++ch) {
                    { const Frame F = make_frame(); const Chunk C = chunk_of(ch); unsigned char* wl = F.ws + WS_W + (size_t)l * WL_STRIDE;
                      pg8::Gemm g{(const pg8::bf16_t*)wsb(F, WS_H) + (size_t)C.r0 * D, (const pg8::bf16_t*)(wl + WL_WIN), C.nr, INP, D};
                      pg8::StaticOrder S; S.init(C.nr, INP, F.G, (int)blockIdx.x);
                      pg8::EpiWin E{F.ws, C.lat ? nullptr : F.out + O_NCK + (size_t)l * 256 * 1024, C.lat ? nullptr : F.out + O_NCV + (size_t)l * 256 * 1024, C.L, C.lshift};
                      pg8::gemm_phase<pg8::EpiWin, pg8::StaticOrder, true, true>(F.lds + RING_OFF, g, S, E); }
                    GRID_BAR();
#define QUEUE_LOOP(qi_, n_, body_) do { gu32* head_ = F.ctl + CW_QUEUE + 64 * ((l * NCHUNK + ch) * 4 + (qi_)); const int n__ = (n_); \
        for (;;) { if (F.tid == 0) F.MISC[16] = __hip_atomic_fetch_add(head_, 1u, __ATOMIC_RELAXED, __HIP_MEMORY_SCOPE_AGENT); \
            __syncthreads(); const int u = __builtin_amdgcn_readfirstlane((int)F.MISC[16]); __syncthreads(); if (u >= n__) break; body_; } } while (0)
                    { const Frame F = make_frame(); const Chunk C = chunk_of(ch);
                      GlaArgs GA{wsb(F, MX_GQ), wsb(F, MX_GK), wsb(F, MX_GVT), wsf(F, MX_GLR), F.in[I_GWA] + (size_t)l * 2 * 16 * 512, F.in[I_GBA] + (size_t)l * 2 * 512,
                                 C.lat ? F.in[I_SG] + (size_t)C.b0 * (2 * 2 * 4 * 128 * 256) : nullptr, wsf(F, MX_OF), wsf(F, MX_OB), C.lat ? nullptr : F.out + O_NSG, C.L, C.nb};
                      QUEUE_LOOP(0, C.nb * 16, gla_unit(F, GA, u, l)); }
                    { const Frame F = make_frame(); const Chunk C = chunk_of(ch);
                      AttnArgs AA{wsb(F, MX_DQ), wsb(F, MX_DK), wsb(F, MX_DVT), C.lat ? wsb(F, WS_CKB) + ((size_t)l * 8 + C.b0) * 256 * 1024 : nullptr,
                                  C.lat ? wsb(F, WS_CVT) + ((size_t)l * 8 + C.b0) * 1024 * 256 : nullptr, wsb(F, MX_YC), F.in[I_DNG] + (size_t)l * 128, F.in[I_DLAM] + (size_t)l * 4 * 64,
                                  l, C.L, C.nb, C.lat ? 16 : 1};
                      QUEUE_LOOP(1, C.lat ? C.nb * 8 * 16 : C.nb * 8, attn_unit(F, AA, u)); }
                    if (ch != 0) { const Frame F = make_frame();
                      HyArgs HA{wsb(F, MX_ZHT), wsb(F, MX_YAT), wsf(F, WS_FILT), F.in[I_HCW] + (size_t)l * 3 * 3072, F.in[I_HCB] + (size_t)l * 3072,
                                F.in[I_HBIAS] + (size_t)l * 2 * 1024, (const cfl*)(F.ws + WS_TW), LLAT, 2};
                      QUEUE_LOOP(2, 1024, hyena_lat_unit(F, HA, u, (cfl*)(F.ws + MX_Y16) + (size_t)blockIdx.x * 4096)); }
                    else { const Frame F = make_frame();
                      HyArgs HA{wsb(F, MX_ZHT), wsb(F, MX_YAT), wsf(F, WS_FILT) + (size_t)4 * 1024 * 4096, F.in[I_HCW] + (size_t)l * 3 * 3072, F.in[I_HCB] + (size_t)l * 3072,
                                F.in[I_HBIAS] + (size_t)l * 2 * 1024, (const cfl*)(F.ws + WS_TW), LCTX, NCTXB};
                      QUEUE_LOOP(3, NCTXB * 512, hyena_ctx_unit(F, HA, u)); }
                    GRID_BAR();
                    { const Frame F = make_frame(); const Chunk C = chunk_of(ch);
                      FinArgs FA{wsf(F, MX_OF), wsf(F, MX_OB), wsb(F, MX_GR), F.in[I_GNG] + (size_t)l * 256, wsb(F, MX_YB), wsb(F, MX_YAT), wsb(F, MX_YA), C.nr, C.L, C.lshift};
                      fin_phase(F, FA); }
                    GRID_BAR();
#pragma unroll 1
                    for (int br = 0; br < 3; ++br) {
                        { const Frame F = make_frame(); const Chunk C = chunk_of(ch); unsigned char* wl = F.ws + WS_W + (size_t)l * WL_STRIDE;
                          pg8::Gemm g{(const pg8::bf16_t*)wsb(F, br == 0 ? MX_YA : br == 1 ? MX_YB : MX_YC), (const pg8::bf16_t*)(wl + WL_WA + (size_t)br * 4 * MiB), C.nr, D, 1024};
                          pg8::StaticOrder S; S.init(C.nr, D, F.G, (int)blockIdx.x);
                          pg8::EpiBranch E{(const pg8::bf16_t*)wsb(F, MX_GT), br * D, wsf(F, MX_YACC), (pg8::bf16_t*)wsb(F, MX_Y16), br};
                          pg8::gemm_phase<pg8::EpiBranch, pg8::StaticOrder, true, true>(F.lds + RING_OFF, g, S, E); }
                        GRID_BAR();
                    }
                    { const Frame F = make_frame(); const Chunk C = chunk_of(ch); unsigned char* wl = F.ws + WS_W + (size_t)l * WL_STRIDE; float* X = F.out;
                      const float* modl = wsf(F, WS_MOD) + (size_t)l * 9 * NMOD;
                      pg8::Gemm g{(const pg8::bf16_t*)wsb(F, MX_Y16), (const pg8::bf16_t*)(wl + WL_WO), C.nr, D, D};
                      pg8::StaticOrder S; S.init(C.nr, D, F.G, (int)blockIdx.x);
                      pg8::EpiResid E{X, X + (size_t)RCTX * D, X, modl + (size_t)5 * D, C.r0 / 256, 1.0f};
                      pg8::gemm_phase<pg8::EpiResid, pg8::StaticOrder, true, true>(F.lds + RING_OFF, g, S, E); }
                    GRID_BAR();
                }
            }
            { const Frame F = make_frame(); const float* modb = wsf(F, WS_MOD);
              const bool last = (l == DEPTH - 1 && s == 2);
              const float* nm = last ? nullptr : modb + (size_t)(s == 2 ? l + 1 : l) * 9 * NMOD;
              ln_phase(F, F.in[I_LNG] + ((size_t)l * 3 + s) * D, F.in[I_LNB] + ((size_t)l * 3 + s) * D, nm, s == 0 ? 3 : s == 1 ? 6 : 0); }
            if (!(l == DEPTH - 1 && s == 2)) GRID_BAR();
        }
    }
}
extern "C" void kernel_launch(void* const* d_in, const int* in_sizes, int n_in, void* d_out, int out_size, void* d_ws, size_t ws_size, hipStream_t stream) {
    static int grid = 0;
    if (grid == 0) {
        if (n_in != N_IN || (size_t)out_size != O_END || ws_size < WS_END) { fprintf(stderr, "kernel_launch: unexpected problem shape (n_in %d out %d ws %zu)\n", n_in, out_size, ws_size); grid = -1; return; }
        int dev = 0, cus = 0;
        if (hipGetDevice(&dev) != hipSuccess || hipDeviceGetAttribute(&cus, hipDeviceAttributeMultiprocessorCount, dev) != hipSuccess) { grid = -1; return; }
        if (hipFuncSetAttribute((const void*)fwd_kernel, hipFuncAttributeMaxDynamicSharedMemorySize, LDS_BYTES) != hipSuccess) { fprintf(stderr, "kernel_launch: hipFuncSetAttribute failed\n"); grid = -1; return; }
        int per_cu = 0;
        if (hipOccupancyMaxActiveBlocksPerMultiprocessor(&per_cu, (const void*)fwd_kernel, NWAVES * 64, LDS_BYTES) != hipSuccess || per_cu < 1) { fprintf(stderr, "kernel_launch: occupancy query says %d\n", per_cu); }
        (void)hipGetLastError();
        grid = cus;
    }
    if (grid < 0) return;
    (void)hipMemsetAsync((char*)d_ws + WS_CTL, 0, CTL_ZERO_BYTES, stream);
    Args a{};
    for (int i = 0; i < N_IN; ++i) a.in[i] = (const float*)d_in[i];
    a.out = (float*)d_out; a.ws = (unsigned char*)d_ws;
    hipLaunchKernelGGL(fwd_kernel, dim3(grid), dim3(NWAVES * 64), LDS_BYTES, stream, a);
}
```

```cpp
#include <hip/hip_runtime.h>
#include <cstdio>
#include <cstdint>
#ifndef DIAG
#define DIAG 0
#endif
namespace pg8 {
#define PG8_LAS __attribute__((address_space(3)))
typedef unsigned short bf16_t;
typedef short bf16x8 __attribute__((ext_vector_type(8)));
typedef float f32x4 __attribute__((ext_vector_type(4)));
typedef unsigned u32x4 __attribute__((ext_vector_type(4)));
constexpr int BM = 256, BK = 64, HALF = 128, HTB = HALF * BK * 2  , STAGE_BYTES = 8 * HTB, NXCD = 8, WGM = 8;

__host__ __device__ __forceinline__ int lds_byte(int r, int c) { const int st = (r >> 4) * 2 + (c >> 5), rr = r & 15, cc = c & 31, ob = rr * 64 + cc * 2; return st * 1024 + (ob ^ (((ob >> 9) & 1) << 5)); }
__host__ __device__ __forceinline__ void stage_rc(int b, int& R, int& C) { const int st = b / 1024, sb = b % 1024, swz = sb ^ (((sb >> 9) & 1) << 5); R = (st >> 1) * 16 + swz / 64; C = (st & 1) * 32 + (swz % 64) / 2; }
__host__ __device__ __forceinline__ int perm32(int rho) { const int n = rho >> 4, i = rho & 15; return 8 * (i >> 2) + 4 * n + (i & 3); }

struct Unit { int pm, pn; };
struct Gemm { const bf16_t* A; const bf16_t* Bt; int M, N, K; int blkA = 0, blkB = 0; };

struct StaticOrder {
    int nM, nN, nwg, G, c;
    __host__ __device__ void init(int M, int N, int G_, int c_) { nM = M / BM; nN = N / BM; nwg = nM * nN; G = G_; c = c_; }
    __host__ __device__ bool next(int i, Unit& u) const {
        const long L = (long)i * G + c; if (L >= nwg) return false;
        int wgid = (int)L; { const int q = nwg / NXCD, r = nwg % NXCD, xcd = wgid % NXCD, off = wgid / NXCD; wgid = (xcd < r ? xcd * (q + 1) : r * (q + 1) + (xcd - r) * q) + off; }
        const int nig = WGM * nN, gid = wgid / nig, fm = gid * WGM, gsz = (nM - fm) < WGM ? (nM - fm) : WGM;
        u.pm = fm + ((wgid % nig) % gsz); u.pn = (wgid % nig) / gsz; return true;
    }
    __device__ __forceinline__ void a_ready(const Unit&) const {}
    __device__ __forceinline__ void done(const Unit&) const {}
};

__device__ __forceinline__ unsigned cvt_pk_bf16(float lo, float hi) { unsigned r; asm volatile("v_cvt_pk_bf16_f32 %0, %1, %2" : "=v"(r) : "v"(lo), "v"(hi)); return r; }
typedef float f32x2 __attribute__((ext_vector_type(2)));
template <class Epi, class Sched, bool ALIGN_EPI = false, bool SP2 = false>
__device__ __forceinline__ void gemm_phase(PG8_LAS unsigned char* lds, const Gemm g, const Sched& S, const Epi& E, const int tid_in) {
    int tid_ = tid_in; asm volatile("" : "+v"(tid_));
    const int tid = tid_, wid = __builtin_amdgcn_readfirstlane(tid >> 6), lane = tid & 63, wr = wid >> 2, wc = wid & 3, fr = lane & 15, fq = lane >> 4;
    const int K = g.K, nt = K / BK;
    unsigned voffA[2], voffB[2];
#pragma unroll
    for (int i = 0; i < 2; ++i) { int R, C; stage_rc(tid * 16 + i * 8192, R, C); const int Rb = Epi::PERM ? ((R & ~31) + perm32(R & 31)) : R;
        voffA[i] = (unsigned)(R * (g.blkA ? 64 : K) + C) * 2u; voffB[i] = (unsigned)(Rb * (g.blkB ? 64 : K) + C) * 2u; }
    const size_t kstepA = g.blkA ? (size_t)32768 : (size_t)(BK * 2), hstepA = g.blkA ? (size_t)16384 : (size_t)HALF * K * 2, tstepA = g.blkA ? (size_t)(K / BK) * 32768 : 2 * hstepA;
    const size_t kstepB = g.blkB ? (size_t)32768 : (size_t)(BK * 2), hstepB = g.blkB ? (size_t)16384 : (size_t)HALF * K * 2, tstepB = g.blkB ? (size_t)(K / BK) * 32768 : 2 * hstepB;
    const unsigned ldsw = (unsigned)wid * 1024u;
    const int aoff = lds_byte(wr * 64 + fr, fq * 8), boff = lds_byte(wc * 32 + fr, fq * 8);
#define PG8_SA(b, h) (((b) * 2 + (h)) * HTB)
#define PG8_SB(b, h) ((4 + (b) * 2 + (h)) * HTB)
#define PG8_STAGE(bufoff, gbase, voff) do { _Pragma("unroll") for (int _i = 0; _i < 2; ++_i) \
        __builtin_amdgcn_global_load_lds((const unsigned*)((const char*)(gbase) + (voff)[_i]), (PG8_LAS unsigned*)(lds + (bufoff) + ldsw + _i * 8192), 16, 0, 0); } while (0)
#define PG8_LDA(dst, b, h) do { _Pragma("unroll") for (int m = 0; m < 4; ++m) _Pragma("unroll") for (int k = 0; k < 2; ++k) dst[m][k] = *(const PG8_LAS bf16x8*)(lds + PG8_SA(b, h) + aoff + m * 2048 + k * 1024); } while (0)
#define PG8_LDB(dst, b, h) do { _Pragma("unroll") for (int n = 0; n < 2; ++n) _Pragma("unroll") for (int k = 0; k < 2; ++k) dst[n][k] = *(const PG8_LAS bf16x8*)(lds + PG8_SB(b, h) + boff + n * 2048 + k * 1024); } while (0)
#define PG8_MMA(ai, bj, At, Bt) do { __builtin_amdgcn_s_setprio(1); _Pragma("unroll") for (int m = 0; m < 4; ++m) _Pragma("unroll") for (int n = 0; n < 2; ++n) _Pragma("unroll") for (int k = 0; k < 2; ++k) \
        acc[ai][bj][m][n] = __builtin_amdgcn_mfma_f32_16x16x32_bf16(Bt[n][k], At[m][k], acc[ai][bj][m][n], 0, 0, 0); __builtin_amdgcn_s_setprio(0); } while (0)
#define PG8_WAIT_V(n) asm volatile("s_waitcnt vmcnt(" #n ")" ::: "memory")
#define PG8_WAIT_L(n) asm volatile("s_waitcnt lgkmcnt(" #n ")" ::: "memory")
#define PG8_BAR __builtin_amdgcn_s_barrier()
#define PG8_SCHED __builtin_amdgcn_sched_barrier(0)
    Unit cur, nxt; int ui = 0;
    if (!S.next(0, cur)) return;
    f32x4 acc[2][2][4][2];
#pragma unroll
    for (int a = 0; a < 2; ++a)
#pragma unroll
        for (int b = 0; b < 2; ++b)
#pragma unroll
            for (int m = 0; m < 4; ++m)
#pragma unroll
                for (int n = 0; n < 2; ++n) acc[a][b][m][n] = (f32x4){0.f, 0.f, 0.f, 0.f};
    bf16x8 At[4][2], B0[2][2], B1[2][2];
    const char* cA = (const char*)g.A + (size_t)cur.pm * tstepA; const char* cB = (const char*)g.Bt + (size_t)cur.pn * tstepB;
    S.a_ready(cur);
    if constexpr (SP2) {
        PG8_STAGE(PG8_SB(0, 0), cB, voffB); PG8_STAGE(PG8_SB(0, 1), cB + hstepB, voffB); PG8_STAGE(PG8_SA(0, 0), cA, voffA); PG8_STAGE(PG8_SA(0, 1), cA + hstepA, voffA);
        if (wr == 1) PG8_BAR;
        PG8_WAIT_V(2); PG8_BAR;
        PG8_STAGE(PG8_SB(1, 0), cB + kstepB, voffB); PG8_STAGE(PG8_SA(1, 0), cA + kstepA, voffA); PG8_STAGE(PG8_SB(1, 1), cB + hstepB + kstepB, voffB);
        PG8_WAIT_V(6); PG8_BAR;
    } else {
        PG8_STAGE(PG8_SB(0, 0), cB, voffB); PG8_STAGE(PG8_SA(0, 0), cA, voffA); PG8_STAGE(PG8_SB(0, 1), cB + hstepB, voffB); PG8_STAGE(PG8_SA(0, 1), cA + hstepA, voffA);
        if (wr == 1) PG8_BAR;
        PG8_WAIT_V(4); PG8_BAR;
        PG8_STAGE(PG8_SB(1, 0), cB + kstepB, voffB); PG8_STAGE(PG8_SA(1, 0), cA + kstepA, voffA); PG8_STAGE(PG8_SB(1, 1), cB + hstepB + kstepB, voffB);
        PG8_WAIT_V(6); PG8_BAR;
    }
    for (;;) {
        const bool has_next = S.next(ui + 1, nxt);
        const char* nA = has_next ? (const char*)g.A + (size_t)nxt.pm * tstepA : cA; const char* nB = has_next ? (const char*)g.Bt + (size_t)nxt.pn * tstepB : cB;
        for (int t = 0; t < nt; t += 2) {
            const bool last = (t == nt - 2);
            const char* a1 = cA + (size_t)(t + 1) * kstepA;
            const char* a2 = last ? nA : cA + (size_t)(t + 2) * kstepA; const char* b2 = last ? nB : cB + (size_t)(t + 2) * kstepB;
            const char* a3 = a2 + kstepA; const char* b3 = b2 + kstepB;
            if (last && has_next) S.a_ready(nxt);
            if constexpr (SP2) {
            PG8_LDB(B0, 0, 0); PG8_LDB(B1, 0, 1); PG8_SCHED; PG8_LDA(At, 0, 0); PG8_STAGE(PG8_SA(1, 1), a1 + hstepA, voffA);
            PG8_WAIT_V(8); PG8_WAIT_L(0); PG8_BAR; PG8_MMA(0, 0, At, B0); PG8_MMA(0, 1, At, B1); PG8_BAR; PG8_SCHED;
            PG8_LDA(At, 0, 1); PG8_STAGE(PG8_SB(0, 0), b2, voffB); PG8_STAGE(PG8_SB(0, 1), b2 + hstepB, voffB); PG8_STAGE(PG8_SA(0, 0), a2, voffA);
            PG8_WAIT_V(8); PG8_WAIT_L(0); PG8_BAR; PG8_MMA(1, 0, At, B0); PG8_MMA(1, 1, At, B1); PG8_BAR; PG8_SCHED;
            PG8_LDB(B0, 1, 0); PG8_LDB(B1, 1, 1); PG8_SCHED; PG8_LDA(At, 1, 0); PG8_STAGE(PG8_SA(0, 1), a2 + hstepA, voffA);
            PG8_WAIT_V(8); PG8_WAIT_L(0); PG8_BAR; PG8_MMA(0, 0, At, B0); PG8_MMA(0, 1, At, B1); PG8_BAR; PG8_SCHED;
            PG8_LDA(At, 1, 1); PG8_STAGE(PG8_SB(1, 0), b3, voffB); PG8_STAGE(PG8_SB(1, 1), b3 + hstepB, voffB); PG8_STAGE(PG8_SA(1, 0), a3, voffA);
            PG8_WAIT_V(8); PG8_WAIT_L(0); PG8_BAR; PG8_MMA(1, 0, At, B0); PG8_MMA(1, 1, At, B1); PG8_BAR; PG8_SCHED;
            } else {
            PG8_LDB(B0, 0, 0); PG8_SCHED; PG8_LDA(At, 0, 0); PG8_STAGE(PG8_SA(1, 1), a1 + hstepA, voffA);
            PG8_WAIT_L(8); PG8_BAR; PG8_WAIT_L(0); PG8_MMA(0, 0, At, B0); PG8_BAR; PG8_SCHED;
            PG8_LDB(B1, 0, 1); PG8_STAGE(PG8_SB(0, 0), b2, voffB);
            PG8_BAR; PG8_WAIT_L(0); PG8_MMA(0, 1, At, B1); PG8_BAR;
            PG8_LDA(At, 0, 1); PG8_STAGE(PG8_SA(0, 0), a2, voffA);
            PG8_BAR; PG8_WAIT_L(0); PG8_MMA(1, 0, At, B0); PG8_BAR; PG8_SCHED;
            PG8_STAGE(PG8_SB(0, 1), b2 + hstepB, voffB);
            PG8_WAIT_V(6); PG8_BAR; PG8_MMA(1, 1, At, B1); PG8_BAR;
            PG8_LDB(B0, 1, 0); PG8_SCHED; PG8_LDA(At, 1, 0); PG8_STAGE(PG8_SA(0, 1), a2 + hstepA, voffA);
            PG8_WAIT_L(8); PG8_BAR; PG8_WAIT_L(0); PG8_MMA(0, 0, At, B0); PG8_BAR; PG8_SCHED;
            PG8_LDB(B1, 1, 1); PG8_STAGE(PG8_SB(1, 0), b3, voffB);
            PG8_BAR; PG8_WAIT_L(0); PG8_MMA(0, 1, At, B1); PG8_BAR;
            PG8_LDA(At, 1, 1); PG8_STAGE(PG8_SA(1, 0), a3, voffA);
            PG8_BAR; PG8_WAIT_L(0); PG8_MMA(1, 0, At, B0); PG8_BAR; PG8_SCHED;
            PG8_STAGE(PG8_SB(1, 1), b3 + hstepB, voffB);
            PG8_WAIT_V(6); PG8_BAR; PG8_MMA(1, 1, At, B1); PG8_BAR;
            }
        }
        if constexpr (ALIGN_EPI) { if (wr == 0) PG8_BAR; }
        if constexpr (!Epi::AFTER_DRAIN) { E(acc, cur, wr, wc, fr, fq); S.done(cur); }
        if (!has_next) break;
#pragma unroll
        for (int a = 0; a < 2; ++a)
#pragma unroll
            for (int b = 0; b < 2; ++b)
#pragma unroll
                for (int m = 0; m < 4; ++m)
#pragma unroll
                    for (int n = 0; n < 2; ++n) acc[a][b][m][n] = (f32x4){0.f, 0.f, 0.f, 0.f};
        cur = nxt; cA = nA; cB = nB; ++ui;
        if constexpr (ALIGN_EPI) { if (wr == 1) PG8_BAR; }
    }
    PG8_WAIT_V(0);
    if constexpr (!ALIGN_EPI) { if (wr == 0) PG8_BAR; }
    PG8_BAR;
    if constexpr (Epi::AFTER_DRAIN) { E.fused(acc, cur, wr, wc, fr, fq, lds, wid, lane); S.done(cur); }
#undef PG8_SA
#undef PG8_SB
#undef PG8_STAGE
#undef PG8_LDA
#undef PG8_LDB
#undef PG8_MMA
#undef PG8_WAIT_V
#undef PG8_WAIT_L
#undef PG8_BAR
#undef PG8_SCHED
}
}
constexpr int D = 2048, FF = 5504, NCTXB = 16, LCTX = 256, NLATB = 8, LLAT = 4096, DEPTH = 2;
constexpr int RCTX = NCTXB * LCTX  , RLAT = NLATB * LLAT  , MTOT = RCTX + RLAT  ;
constexpr int NMODV = 9, NMOD = 9 * D  ;
constexpr int HYW = 1024, FH = 64, HYEMB = 17;
constexpr int GH = 4, GDK = 128, GDV = 256, GRANK = 16;
constexpr int AH = 8, ADH = 64, ADV = 128;
constexpr int INC = 15392, INP = 15616;
constexpr int NCHUNK = 5;
constexpr float ALPHA = 1.4142135623730951f;
constexpr float LN_EPS = 1e-5f, RMS_EPS = 1e-6f;
constexpr float LOG2E = 1.4426950408889634f;
enum { I_XP = 0, I_XS, I_CK, I_CV, I_SG, I_C, I_CCTX, I_WMOD, I_BMOD, I_LNG, I_LNB, I_W1, I_W3, I_W2, I_WIN, I_HCW, I_HCB, I_HW1, I_HB1, I_HFREQ, I_HW2, I_HB2,
       I_HW3, I_HDEC, I_HBIAS, I_GWA, I_GBA, I_GNG, I_DLAM, I_DNG, I_WBA, I_WBB, I_WBC, I_WOUT, N_IN };
constexpr size_t O_YP = 0, O_YS = (size_t)RCTX * D, O_NCK = (size_t)MTOT * D, O_NCV = O_NCK + 8388608, O_NSG = O_NCV + 8388608, O_END = O_NSG + 8388608;
constexpr size_t MiB = 1u << 20;
constexpr size_t WS_CTL = 0, CTL_ZERO_BYTES = 1 * MiB;
constexpr size_t WS_MOD = 1 * MiB;
constexpr size_t WS_ROPE = 3 * MiB;
constexpr size_t WS_HDN = 4 * MiB;
constexpr size_t WS_CKB = 8 * MiB;
constexpr size_t WS_CVT = 16 * MiB;
constexpr size_t WS_TW = 24 * MiB;
constexpr size_t WS_W = 25 * MiB;
constexpr size_t WL_W13 = 0, WL_W2 = 86 * MiB, WL_WIN = 129 * MiB, WL_WA = 190 * MiB, WL_WB = 194 * MiB, WL_WC = 198 * MiB, WL_WO = 202 * MiB, WL_STRIDE = 210 * MiB;
constexpr size_t WS_SPEC = WS_W + 2 * WL_STRIDE;
constexpr size_t WS_FILTC = WS_SPEC + 144 * MiB;
constexpr size_t WS_H = WS_FILTC + 4 * MiB;
constexpr size_t WS_BIG = WS_H + 144 * MiB;
constexpr size_t WS_FILTL = WS_BIG;
constexpr size_t WS_U = WS_BIG;
constexpr size_t MX_ZHT = WS_BIG;
constexpr size_t MX_GQ = MX_ZHT + 48 * MiB;
constexpr size_t MX_GK = MX_GQ + 8 * MiB;
constexpr size_t MX_GVT = MX_GK + 8 * MiB;
constexpr size_t MX_GR = MX_GVT + 16 * MiB;
constexpr size_t MX_GLR = MX_GR + 16 * MiB;
constexpr size_t MX_DQ = MX_GLR + 1 * MiB;
constexpr size_t MX_DK = MX_DQ + 16 * MiB;
constexpr size_t MX_DVT = MX_DK + 16 * MiB;
constexpr size_t MX_GT = MX_DVT + 16 * MiB;
constexpr size_t MX_OF = MX_GT + 96 * MiB;
constexpr size_t MX_OB = MX_OF + 32 * MiB;
constexpr size_t MX_YAT = MX_OB + 32 * MiB;
constexpr size_t MX_YA = MX_YAT + 16 * MiB;
constexpr size_t MX_YB = MX_YA + 16 * MiB;
constexpr size_t MX_YC = MX_YB + 16 * MiB;
constexpr size_t MX_YACC = MX_ZHT;
constexpr size_t MX_Y16 = MX_YC + 16 * MiB;
constexpr size_t MX_END = MX_Y16 + 32 * MiB;
constexpr size_t WS_END = (MX_END > WS_U + 388 * MiB) ? MX_END : WS_U + 388 * MiB;
static_assert(WS_END <= 1152 * MiB, "workspace map must stay under 4 x the largest tensor");
constexpr int CW_TMO = 0, CW_ERR = 64  , CW_BAR = 4096;
constexpr int NWAVES = 8;
constexpr int RING_OFF = 0, RING_BYTES = 147456;
constexpr int LDSCTL_OFF = RING_BYTES, MISC_OFF = LDSCTL_OFF + 320;
constexpr int LDS_BYTES = RING_BYTES + 4096;
#define GAS __attribute__((address_space(1)))
#define LAS __attribute__((address_space(3)))
typedef unsigned short bf16;
typedef unsigned v4u __attribute__((ext_vector_type(4)));
typedef float f32x4 __attribute__((ext_vector_type(4)));
typedef short bf16x8 __attribute__((ext_vector_type(8)));
typedef GAS unsigned gu32;
typedef GAS unsigned long long gu64;
#define RLX_AGENT __ATOMIC_RELAXED, __HIP_MEMORY_SCOPE_AGENT
#define LDS_WAIT() asm volatile("s_waitcnt lgkmcnt(0)" ::: "memory")
#define VM_WAIT() asm volatile("s_waitcnt vmcnt(0)" ::: "memory")
__device__ __forceinline__ unsigned long long rt() { return __builtin_amdgcn_s_memrealtime(); }
__device__ __forceinline__ unsigned f2bf(float f) { unsigned u = __builtin_bit_cast(unsigned, f); return (u + 0x7fffu + ((u >> 16) & 1u)) >> 16; }
__device__ __forceinline__ unsigned pk2(float lo, float hi) { return f2bf(lo) | (f2bf(hi) << 16); }

#define XB_TMO      128
#define XB_XCNT(j)  (256  + 64 * (j))
#define XB_XSUB(j)  (1280 + 64 * (j))
#define XB_XGEN(j)  (2304 + 64 * (j))
#define XB_TOP      3328
#define XB_TOPGEN   3392
#define XCD_BAR_WORDS 3456
#define XB_SPIN_CAP (1u << 18)

__device__ __forceinline__ unsigned xb_ld(unsigned* p)              { return __hip_atomic_load(p, __ATOMIC_RELAXED, __HIP_MEMORY_SCOPE_AGENT); }
__device__ __forceinline__ unsigned xb_add(unsigned* p, unsigned v) { return __hip_atomic_fetch_add(p, v, __ATOMIC_RELAXED, __HIP_MEMORY_SCOPE_AGENT); }
__device__ __forceinline__ unsigned xb_xcc_id() { return (unsigned)__builtin_amdgcn_s_getreg((3 << 11) | 20) & 0xFu; }
#define XB_SPIN(cond, bar) do { unsigned _sp = 0; while (cond) { __builtin_amdgcn_s_sleep(1); \
    if ((++_sp & 255u) == 0u) { if (xb_ld(&(bar)[XB_TMO])) break; if (_sp > XB_SPIN_CAP) { atomicAdd(&(bar)[XB_TMO], 1u); break; } } } } while (0)

struct XcdBarrier {
    unsigned* bar; unsigned x;
    volatile LAS unsigned* st;
};

__device__ __forceinline__ XcdBarrier xcd_barrier_post(unsigned* bar, volatile LAS unsigned* st) {
    XcdBarrier b; b.bar = bar; b.x = xb_xcc_id(); b.st = st;
    if (threadIdx.x == 0) (void)xb_add(&bar[XB_XCNT(b.x)], 1u);
    return b;
}
__device__ __forceinline__ void xcd_barrier_complete(unsigned* bar, unsigned x, unsigned& nloc, unsigned& nx) {
    const unsigned G = gridDim.x * gridDim.y * gridDim.z;
    unsigned sum, cnt, mine, sp = 0u;
    for (;;) {
        sum = 0u; cnt = 0u; mine = 0u;
#pragma unroll
        for (unsigned j = 0; j < 16; ++j) { const unsigned c = xb_ld(&bar[XB_XCNT(j)]); sum += c; cnt += (c > 0u) ? 1u : 0u; mine = (j == x) ? c : mine; }
        if (sum == G) break;
        __builtin_amdgcn_s_sleep(1);
        if ((++sp & 255u) == 0u) { if (xb_ld(&bar[XB_TMO])) break; if (sp > XB_SPIN_CAP) { atomicAdd(&bar[XB_TMO], 1u); break; } }
    }
    nloc = mine > 0u ? mine : 1u; nx = cnt > 0u ? cnt : 1u;
}

__device__ __forceinline__ void xcd_barrier(const XcdBarrier& b) {
    asm volatile("s_waitcnt vmcnt(0)" ::: "memory");
    __syncthreads();
    if (threadIdx.x == 0) {
        unsigned* bar = b.bar;
        __builtin_amdgcn_s_waitcnt(0);
        unsigned nloc = b.st[0], nx = b.st[1];
        if (nloc == 0u) { xcd_barrier_complete(bar, b.x, nloc, nx); b.st[0] = nloc; b.st[1] = nx; }
        const unsigned old = xb_add(&bar[XB_XSUB(b.x)], 1u);
        const unsigned gen = old / nloc;
        if (old + 1u == (gen + 1u) * nloc) {
            __builtin_amdgcn_fence(__ATOMIC_RELEASE, "agent");
            asm volatile("s_waitcnt vmcnt(0)" ::: "memory");
            const unsigned og = xb_add(&bar[XB_TOP], 1u);
            const unsigned tg = og / nx;
            if (og + 1u == (tg + 1u) * nx) xb_add(&bar[XB_TOPGEN], 1u);
            else XB_SPIN(xb_ld(&bar[XB_TOPGEN]) == tg, bar);
            __builtin_amdgcn_fence(__ATOMIC_ACQUIRE, "agent");
            xb_add(&bar[XB_XGEN(b.x)], 1u);
            asm volatile("s_waitcnt vmcnt(0)" ::: "memory");
        } else {
            XB_SPIN(xb_ld(&bar[XB_XGEN(b.x)]) == gen, bar);
            __builtin_amdgcn_fence(__ATOMIC_ACQUIRE, "agent");
            asm volatile("s_waitcnt vmcnt(0)" ::: "memory");
        }
    }
    __syncthreads();
}
namespace pg8 {
__device__ __forceinline__ float fast_rcp(float x) { return __builtin_amdgcn_rcpf(x); }
__device__ __forceinline__ float sigmoid_f(float x) { return fast_rcp(1.0f + __builtin_amdgcn_exp2f(-x * 1.4426950408889634f)); }
__device__ __forceinline__ float silu_f(float x) { return x * sigmoid_f(x); }
__device__ __forceinline__ unsigned short bf1(float f) { unsigned u = __builtin_bit_cast(unsigned, f); return (unsigned short)((u + 0x7fffu + ((u >> 16) & 1u)) >> 16); }
__device__ __forceinline__ int mod_of_tile(int gpm) { return gpm < 16 ? 0 : 1 + ((gpm - 16) >> 4); }

struct EpiSwiglu {
    static constexpr bool PERM = true, AFTER_DRAIN = false;
    bf16_t* U; int ldu;
    __device__ __forceinline__ void operator()(const f32x4 (&acc)[2][2][4][2], const Unit& u, int wr, int wc, int fr, int fq) const {
        const int row0 = u.pm * BM + wr * 64 + fr, col0 = u.pn * 128 + wc * 32 + 8 * fq;
#pragma unroll
        for (int ai = 0; ai < 2; ++ai)
#pragma unroll
            for (int m = 0; m < 4; ++m) {
                const f32x4 a0 = acc[ai][0][m][0], a1 = acc[ai][0][m][1], b0 = acc[ai][1][m][0], b1 = acc[ai][1][m][1];
                u32x4 w;
                w.x = cvt_pk_bf16(silu_f(a0[0]) * b0[0], silu_f(a0[1]) * b0[1]); w.y = cvt_pk_bf16(silu_f(a0[2]) * b0[2], silu_f(a0[3]) * b0[3]);
                w.z = cvt_pk_bf16(silu_f(a1[0]) * b1[0], silu_f(a1[1]) * b1[1]); w.w = cvt_pk_bf16(silu_f(a1[2]) * b1[2], silu_f(a1[3]) * b1[3]);
                const int row = row0 + ai * HALF + m * 16;
                *(u32x4*)(U + ((size_t)((row >> 8) * (ldu >> 6) + (col0 >> 6)) * 256 + (row & 255)) * 64 + (col0 & 63)) = w;
            }
    }
};
struct EpiResid {
    static constexpr bool PERM = false, AFTER_DRAIN = false;
    const float* xs_ctx; const float* xs_lat;
    float* X; const float* gate;
    int pm0; float gs; float alpha;
    __device__ __forceinline__ void operator()(const f32x4 (&acc)[2][2][4][2], const Unit& u, int wr, int wc, int fr, int fq) const {
        const int gpm = u.pm + pm0; const float* g = gate + (size_t)mod_of_tile(gpm) * NMOD;
        const int row0 = gpm * BM + wr * 64 + fr, col0 = u.pn * BM + wc * 32 + 4 * fq;
        f32x4 gv[2][2];
#pragma unroll
        for (int bj = 0; bj < 2; ++bj)
#pragma unroll
            for (int n = 0; n < 2; ++n) gv[bj][n] = *(const f32x4*)(g + col0 + bj * HALF + n * 16) * gs;
#pragma unroll
        for (int ai = 0; ai < 2; ++ai)
#pragma unroll
            for (int m = 0; m < 4; ++m) {
                const int row = row0 + ai * HALF + m * 16;
                const float* src = (row < RCTX ? xs_ctx + (size_t)row * D : xs_lat + (size_t)(row - RCTX) * D) + col0;
                float* dst = X + (size_t)row * D + col0;
#pragma unroll
                for (int bj = 0; bj < 2; ++bj)
#pragma unroll
                    for (int n = 0; n < 2; ++n) { const f32x4 xv = *(const f32x4*)(src + bj * HALF + n * 16);
                        *(f32x4*)(dst + bj * HALF + n * 16) = xv * alpha + gv[bj][n] * acc[ai][bj][m][n]; }
            }
    }
};
struct EpiBranch {
    static constexpr bool PERM = false, AFTER_DRAIN = false;
    const bf16_t* Gt; int gcol0; float* Yacc; bf16_t* Y16; int mode;
    __device__ __forceinline__ void operator()(const f32x4 (&acc)[2][2][4][2], const Unit& u, int wr, int wc, int fr, int fq) const {
        const int row0 = u.pm * BM + wr * 64 + fr, col0 = u.pn * BM + wc * 32 + 4 * fq;
#pragma unroll
        for (int ai = 0; ai < 2; ++ai)
#pragma unroll
            for (int m = 0; m < 4; ++m) {
                const size_t row = (size_t)(row0 + ai * HALF + m * 16);
#pragma unroll
                for (int bj = 0; bj < 2; ++bj)
#pragma unroll
                    for (int n = 0; n < 2; ++n) { const int c = col0 + bj * HALF + n * 16;
                        const uint2 gw = *(const uint2*)(Gt + row * 6144 + gcol0 + c);
                        f32x4 g; g[0] = __uint_as_float(gw.x << 16); g[1] = __uint_as_float(gw.x & 0xffff0000u); g[2] = __uint_as_float(gw.y << 16); g[3] = __uint_as_float(gw.y & 0xffff0000u);
                        f32x4 v = g * acc[ai][bj][m][n];
                        if (mode != 0) { const uint2 yw = *(const uint2*)(Y16 + row * D + c);
                            v[0] += __uint_as_float(yw.x << 16); v[1] += __uint_as_float(yw.x & 0xffff0000u); v[2] += __uint_as_float(yw.y << 16); v[3] += __uint_as_float(yw.y & 0xffff0000u); }
                        uint2 o; o.x = cvt_pk_bf16(v[0], v[1]); o.y = cvt_pk_bf16(v[2], v[3]); *(uint2*)(Y16 + row * D + c) = o; }
            }
    }
};
struct EpiWin {
    static constexpr bool PERM = false, AFTER_DRAIN = false;
    unsigned char* ws;
    float *nck, *ncv;
    int L, lshift;
    __device__ __forceinline__ void operator()(const f32x4 (&acc)[2][2][4][2], const Unit& u, int wr, int wc, int fr, int fq) const {
        const int pn = u.pn; const int row0 = u.pm * BM + wr * 64 + fr;
        const int cw = wc * 32 + 4 * fq;
        if (pn < 12 || (pn >= 16 && pn < 20) || (pn >= 32 && pn < 36)) {
            bf16_t* T; int W, cb;
            if (pn < 12) { T = (bf16_t*)(ws + MX_ZHT); W = 3072; cb = pn * 256; } else if (pn < 20) { T = (bf16_t*)(ws + MX_GVT); W = 1024; cb = (pn - 16) * 256; } else { T = (bf16_t*)(ws + MX_DVT); W = 1024; cb = (pn - 32) * 256; }
            const bool cache = (pn >= 32) && (ncv != nullptr);
            const unsigned Lu = (unsigned)L;
#pragma unroll
            for (int ai = 0; ai < 2; ++ai)
#pragma unroll
                for (int m = 0; m < 4; ++m) { const int rl = row0 + ai * HALF + m * 16; const int b = rl >> lshift, t = rl & (L - 1);
                    bf16_t* Tr = T + ((size_t)b * W + cb + cw) * Lu + t;
#pragma unroll
                    for (int bj = 0; bj < 2; ++bj)
#pragma unroll
                        for (int n = 0; n < 2; ++n) { const f32x4 v = acc[ai][bj][m][n]; const unsigned co = (unsigned)(bj * HALF + n * 16) * Lu;
#pragma unroll
                            for (int i = 0; i < 4; ++i) Tr[co + (unsigned)i * Lu] = bf1(v[i]);
                            if (cache) *(f32x4*)(ncv + ((size_t)b * 2 * 256 + t) * 1024 + cb + bj * HALF + cw + n * 16) = v; } }
            return;
        }
        if (pn == 60) {
            if (wc == 0) {
#pragma unroll
                for (int ai = 0; ai < 2; ++ai)
#pragma unroll
                    for (int m = 0; m < 4; ++m) { const int rl = row0 + ai * HALF + m * 16;
#pragma unroll
                        for (int n = 0; n < 2; ++n) *(f32x4*)((float*)(ws + MX_GLR) + (size_t)rl * 32 + 4 * fq + n * 16) = acc[ai][0][m][n]; } }
            return;
        }
        if (pn >= 24 && pn < 32) {
            const bool isq = pn < 28; bf16_t* O = (bf16_t*)(ws + (isq ? MX_DQ : MX_DK)); const float* rope = (const float*)(ws + WS_ROPE); const int cb = (pn - (isq ? 24 : 28)) * 256;
            const float sc = isq ? 0.125f * LOG2E : 1.0f; const bool lat = (nck == nullptr);
#pragma unroll
            for (int ai = 0; ai < 2; ++ai)
#pragma unroll
                for (int m = 0; m < 4; ++m) { const int rl = row0 + ai * HALF + m * 16; const int t = rl & (L - 1);
                    f32x4 cs = {1.f, 1.f, 1.f, 1.f}, sn = {0.f, 0.f, 0.f, 0.f};
                    if (lat) { cs = *(const f32x4*)(rope + (size_t)t * 32 + (wc & 1) * 16 + 4 * fq); sn = *(const f32x4*)(rope + 4096 * 32 + (size_t)t * 32 + (wc & 1) * 16 + 4 * fq); }
#pragma unroll
                    for (int bj = 0; bj < 2; ++bj) { const f32x4 x1 = acc[ai][bj][m][0], x2 = acc[ai][bj][m][1]; const int c = cb + bj * HALF + cw;
                        if (!isq && !lat) { const int b = rl >> lshift; float* kc = nck + ((size_t)b * 2 * 256 + t) * 1024 + c; *(f32x4*)kc = x1; *(f32x4*)(kc + 16) = x2; }
                        const f32x4 o1 = (x1 * cs - x2 * sn) * sc, o2 = (x1 * sn + x2 * cs) * sc;
                        uint2 w1; w1.x = cvt_pk_bf16(o1[0], o1[1]); w1.y = cvt_pk_bf16(o1[2], o1[3]); uint2 w2; w2.x = cvt_pk_bf16(o2[0], o2[1]); w2.y = cvt_pk_bf16(o2[2], o2[3]);
                        *(uint2*)(O + (size_t)rl * 1024 + c) = w1; *(uint2*)(O + (size_t)rl * 1024 + c + 16) = w2; } }
            return;
        }
        bf16_t* O; int ld, cb, act;
        if (pn < 14) { O = (bf16_t*)(ws + MX_GQ); ld = 512; cb = (pn - 12) * 256; act = 1; } else if (pn < 16) { O = (bf16_t*)(ws + MX_GK); ld = 512; cb = (pn - 14) * 256; act = 0; }
        else if (pn < 24) { O = (bf16_t*)(ws + MX_GR); ld = 1024; cb = (pn - 20) * 256; act = 2; } else { O = (bf16_t*)(ws + MX_GT); ld = 6144; cb = (pn - 36) * 256; act = 3; }
#pragma unroll
        for (int ai = 0; ai < 2; ++ai)
#pragma unroll
            for (int m = 0; m < 4; ++m) { const int rl = row0 + ai * HALF + m * 16;
#pragma unroll
                for (int bj = 0; bj < 2; ++bj)
#pragma unroll
                    for (int n = 0; n < 2; ++n) { f32x4 v = acc[ai][bj][m][n];
                        if (act == 1) v = v * 0.08838834764831845f;
                        else if (act == 2) { v[0] = silu_f(v[0]); v[1] = silu_f(v[1]); v[2] = silu_f(v[2]); v[3] = silu_f(v[3]); }
                        else if (act == 3) { v[0] = sigmoid_f(v[0]); v[1] = sigmoid_f(v[1]); v[2] = sigmoid_f(v[2]); v[3] = sigmoid_f(v[3]); }
                        uint2 w; w.x = cvt_pk_bf16(v[0], v[1]); w.y = cvt_pk_bf16(v[2], v[3]);
                        *(uint2*)(O + (size_t)rl * ld + cb + bj * HALF + cw + n * 16) = w; } }
    }
};
}
typedef float f32x2g __attribute__((ext_vector_type(2)));
typedef unsigned u32x2 __attribute__((ext_vector_type(2)));
struct Args { const float* in[N_IN]; float* out; unsigned char* ws; };
typedef const __attribute__((address_space(4))) Args* CArgsP;
struct InTab { CArgsP ap; __device__ __forceinline__ const float* operator[](int i) const { return ap->in[i]; } };
struct Frame {
    LAS unsigned char* lds; volatile LAS unsigned* MISC; gu32* ctl;
    int tid, lane, wave, G, gw, NGW;
    InTab in; float* out; unsigned char* ws;
};
__device__ __forceinline__ Frame make_frame(int wv  ) {
    CArgsP ap = (CArgsP)__builtin_amdgcn_kernarg_segment_ptr(); asm volatile("" : "+s"(ap));
    extern __shared__ __attribute__((aligned(16))) unsigned char lds_raw[];
    Frame F; F.lds = (LAS unsigned char*)lds_raw; F.MISC = (volatile LAS unsigned*)(F.lds + MISC_OFF);
    { int ln_ = (int)__builtin_amdgcn_mbcnt_hi(~0u, __builtin_amdgcn_mbcnt_lo(~0u, 0u)); asm volatile("" : "+v"(ln_)); F.lane = ln_; } F.wave = wv; F.tid = wv * 64 + F.lane;
    F.G = gridDim.x; F.gw = blockIdx.x * NWAVES + F.wave; F.NGW = F.G * NWAVES;
    F.in.ap = ap; F.out = ap->out; F.ws = ap->ws; F.ctl = (gu32*)(F.ws + WS_CTL);
    return F;
}
__device__ __forceinline__ float shflx(float v, int mask, int lane) { return __uint_as_float((unsigned)__builtin_amdgcn_ds_bpermute((lane ^ mask) << 2, (int)__float_as_uint(v))); }
__device__ __forceinline__ float wave_sum(float v, int lane) {
#pragma unroll
    for (int o = 1; o < 64; o <<= 1) v += shflx(v, o, lane);
    return v;
}
__device__ __forceinline__ float bf2f(bf16 h) { return __uint_as_float((unsigned)h << 16); }
__device__ __forceinline__ bf16 f2b(float f) { return (bf16)f2bf(f); }
__device__ __forceinline__ float sigmoidf_(float x) { return 1.0f / (1.0f + __expf(-x)); }
__device__ __forceinline__ float siluf_(float x) { return x * sigmoidf_(x); }
__device__ __forceinline__ bf16* wsb(const Frame& F, size_t off) { return (bf16*)(F.ws + off); }
__device__ __forceinline__ float* wsf(const Frame& F, size_t off) { return (float*)(F.ws + off); }
__device__ __forceinline__ int mod_of_row(int row) { return row < RCTX ? 0 : 1 + ((row - RCTX) >> 12); }
__device__ __forceinline__ const float* xin_row(const Frame& F, int row) { return row < RCTX ? F.in[I_XP] + (size_t)row * D : F.in[I_XS] + (size_t)(row - RCTX) * D; }

__device__ __forceinline__ void transpose_item(const float* src, int ldn, int K, bf16* dst, int k0, LAS float* scr, int lane) {
    if (src == nullptr) {
        const int c = lane & 7;
#pragma unroll
        for (int j = 0; j < 4; ++j) { const int n = (lane >> 3) + 8 * j; *(GAS v4u*)(dst + (size_t)n * K + k0 + 8 * c) = (v4u){0u, 0u, 0u, 0u}; }
        return;
    }
#pragma unroll 8
    for (int i = 0; i < 32; ++i) { const int kk = 2 * i + (lane >> 5); scr[kk * 33 + (lane & 31)] = src[(size_t)(k0 + kk) * ldn + (lane & 31)]; }
    LDS_WAIT(); asm volatile("" ::: "memory");
    const int c = lane & 7;
#pragma unroll
    for (int j = 0; j < 4; ++j) { const int n = (lane >> 3) + 8 * j; const LAS float* s = scr + (8 * c) * 33 + n;
        v4u o; o.x = pk2(s[0 * 33], s[1 * 33]); o.y = pk2(s[2 * 33], s[3 * 33]); o.z = pk2(s[4 * 33], s[5 * 33]); o.w = pk2(s[6 * 33], s[7 * 33]);
        *(GAS v4u*)(dst + (size_t)n * K + k0 + 8 * c) = o; }
    LDS_WAIT(); asm volatile("" ::: "memory");
}
constexpr int IT_W13 = 2 * 344 * 32, IT_W2 = 2 * 64 * 86, IT_WIN = 488 * 32, IT_BR = 64 * 16, IT_WO = 64 * 32, IT_LAYER = IT_W13 + IT_W2 + IT_WIN + 3 * IT_BR + IT_WO;
__device__ __forceinline__ void convert_item(const Frame& F, int l, int it, LAS float* scr) {
    unsigned char* wl = F.ws + WS_W + (size_t)l * WL_STRIDE;
    if (it < IT_W13) { const int s = it / (344 * 32), r = it % (344 * 32), nb = r / 32, kb = r % 32; const int n0 = nb * 32, pn = n0 >> 8, j = n0 & 255;
        const float* src = (j < 128 ? F.in[I_W1] : F.in[I_W3]) + ((size_t)(l * 2 + s) * D) * FF + pn * 128 + (j & 127);
        transpose_item(src, FF, D, (bf16*)(wl + WL_W13) + ((size_t)s * 11008 + n0) * D, kb * 64, scr, F.lane); return; }
    it -= IT_W13;
    if (it < IT_W2) { const int s = it / (64 * 86), r = it % (64 * 86), nb = r / 86, kb = r % 86;
        const float* src = F.in[I_W2] + ((size_t)(l * 2 + s) * FF) * D + nb * 32;
        transpose_item(src, D, FF, (bf16*)(wl + WL_W2) + ((size_t)s * D + nb * 32) * FF, kb * 64, scr, F.lane); return; }
    it -= IT_W2;
    if (it < IT_WIN) { const int nb = it / 32, kb = it % 32, n0 = nb * 32;
        int oc = n0 < 6144 ? n0 : (n0 < 15360 ? n0 + 32 : (n0 < INC ? n0 - 15360 + 6144 : -1));
        const float* src = oc >= 0 ? F.in[I_WIN] + (size_t)l * D * INC + oc : nullptr;
        transpose_item(src, INC, D, (bf16*)(wl + WL_WIN) + (size_t)n0 * D, kb * 64, scr, F.lane); return; }
    it -= IT_WIN;
    if (it < 3 * IT_BR) { const int w = it / IT_BR, r = it % IT_BR, nb = r / 16, kb = r % 16;
        const float* src = F.in[I_WBA + w] + (size_t)l * 1024 * D + nb * 32;
        transpose_item(src, D, 1024, (bf16*)(wl + WL_WA + (size_t)w * 4 * MiB) + (size_t)nb * 32 * 1024, kb * 64, scr, F.lane); return; }
    it -= 3 * IT_BR;
    { const int nb = it / 32, kb = it % 32;
        const float* src = F.in[I_WOUT] + (size_t)l * D * D + nb * 32;
        transpose_item(src, D, D, (bf16*)(wl + WL_WO) + (size_t)nb * 32 * D, kb * 64, scr, F.lane); }
}
__device__ __forceinline__ void mod_unit(const Frame& F, int unit) {
    LAS float* sc = (LAS float*)(F.lds);
    LAS float* red = (LAS float*)(F.lds + 9 * D * 4);
    const int l = unit / 144, n0 = (unit % 144) * 128;
    for (int i = F.tid; i < 9 * D; i += 512) { const int m = i / D, k = i % D; const float c = m == 0 ? F.in[I_CCTX][k] : F.in[I_C][(size_t)(m - 1) * D + k]; sc[i] = siluf_(c); }
    __syncthreads();
    float a0[9], a1[9];
#pragma unroll
    for (int m = 0; m < 9; ++m) { a0[m] = 0.f; a1[m] = 0.f; }
    const float* w = F.in[I_WMOD] + ((size_t)l * D + F.wave * 256) * NMOD + n0 + 2 * F.lane;
#pragma unroll 4
    for (int k = 0; k < 256; ++k) { const float2 wv = *(const float2*)(w + (size_t)k * NMOD);
#pragma unroll
        for (int m = 0; m < 9; ++m) { const float s = sc[m * D + F.wave * 256 + k]; a0[m] += s * wv.x; a1[m] += s * wv.y; } }
#pragma unroll
    for (int m = 0; m < 9; ++m) { red[(F.wave * 9 + m) * 128 + 2 * F.lane] = a0[m]; red[(F.wave * 9 + m) * 128 + 2 * F.lane + 1] = a1[m]; }
    __syncthreads();
    for (int i = F.tid; i < 9 * 128; i += 512) { const int m = i / 128, c = i % 128; float s = F.in[I_BMOD][(size_t)l * NMOD + n0 + c];
#pragma unroll
        for (int wv = 0; wv < 8; ++wv) s += red[(wv * 9 + m) * 128 + c];
        wsf(F, WS_MOD)[((size_t)l * 9 + m) * NMOD + n0 + c] = s; }
    __syncthreads();
}
__device__ __forceinline__ void p0_prologue(const Frame& F) {
    for (int u = blockIdx.x; u < 2 * 144; u += F.G) mod_unit(F, u);
    LAS float* scr = (LAS float*)(F.lds + F.wave * 16384);
    for (int it = F.gw; it < 2 * IT_LAYER; it += F.NGW) convert_item(F, it / IT_LAYER, it % IT_LAYER, scr);
    const int gt = blockIdx.x * 512 + F.tid, NGT = F.G * 512;
    { float* rp = wsf(F, WS_ROPE);
      for (int i = gt; i < 4096 * 32; i += NGT) { const int t = i >> 5, ax = (i >> 4) & 1, f = i & 15; const float inv = powf(10000.0f, -(float)f / 16.0f);
          const float pos = (float)(ax == 0 ? (t >> 6) : (t & 63)); const float ang = pos * inv; rp[i] = cosf(ang); rp[4096 * 32 + i] = sinf(ang); } }
    { f32x2g* tw = (f32x2g*)(F.ws + WS_TW);
      for (int i = gt; i < 8192; i += NGT) { float s, c; sincospif(-(float)i / 4096.0f, &s, &c); tw[i] = (f32x2g){c, s}; } }
    { bf16* ck = wsb(F, WS_CKB); const float* src = F.in[I_CK];
      for (int i = gt; i < 2 * 8 * 256 * 1024; i += NGT) { const int c = i & 1023, t = (i >> 10) & 255, b = (i >> 18) & 7, l = i >> 21;
          ck[i] = f2b(src[(((size_t)b * 2 + l) * 256 + t) * 1024 + c]); } }
    { bf16* cv = wsb(F, WS_CVT); const float* src = F.in[I_CV];
      for (int i = gt; i < 2 * 8 * 256 * 1024; i += NGT) { const int t = i & 255, c = (i >> 8) & 1023, b = (i >> 18) & 7, l = i >> 21;
          cv[i] = f2b(src[(((size_t)b * 2 + l) * 256 + t) * 1024 + c]); } }
    { float* hd = wsf(F, WS_HDN);
      for (int r = F.gw; r < 2 * (256 + 4096); r += F.NGW) { const int l = r / 4352, q = r % 4352, ls = q < 256 ? 0 : 1, t = ls ? q - 256 : q, L = ls ? 4096 : 256;
          const float tt = (float)t / (float)(L - 1), w = (6.283185307179586f / (float)L) * (float)t; const int j = F.lane;
          const float* w1 = F.in[I_HW1] + (size_t)l * HYEMB * FH; float a = F.in[I_HB1][l * FH + j] + tt * w1[j];
#pragma unroll
          for (int m = 0; m < 8; ++m) { const float f = 1e-4f + (float)m * ((7.0f - 1e-4f) / 7.0f); const float ph = w * f; a += cosf(ph) * w1[(1 + m) * FH + j] - sinf(ph) * w1[(9 + m) * FH + j]; }
          const float h1 = sinf(F.in[I_HFREQ][(l * 2 + 0) * FH + j] * a);
          float a2 = F.in[I_HB2][l * FH + j]; const float* w2 = F.in[I_HW2] + (size_t)l * FH * FH;
          for (int i = 0; i < 64; ++i) a2 += __uint_as_float((unsigned)__builtin_amdgcn_readlane((int)__float_as_uint(h1), i)) * w2[i * FH + j];
          hd[(((size_t)l * 2 + ls) * 4096 + t) * FH + j] = sinf(F.in[I_HFREQ][(l * 2 + 1) * FH + j] * a2); } }
}
__device__ __forceinline__ void p0_h0(const Frame& F) {
    const float* md = wsf(F, WS_MOD);
    for (int row = F.gw; row < MTOT; row += F.NGW) {
        const float* x = xin_row(F, row); const float* sh = md + (size_t)mod_of_row(row) * NMOD; const float* scl = sh + D; bf16* h = wsb(F, WS_H) + (size_t)row * D;
#pragma unroll
        for (int j = 0; j < 8; ++j) { const int c = 4 * (64 * j + F.lane); const f32x4 v = *(const f32x4*)(x + c), a = *(const f32x4*)(sh + c), s = *(const f32x4*)(scl + c);
            const f32x4 o = v * (s + 1.0f) + a; uint2 w; w.x = pk2(o[0], o[1]); w.y = pk2(o[2], o[3]); *(uint2*)(h + c) = w; }
    }
}
__device__ __forceinline__ void ln_phase(const Frame& F, const float* g, const float* b, const float* modl  , int shift_idx, bool dummy = false) {
    float* X = F.out;
    for (int row = F.gw; row < MTOT; row += F.NGW) {
        float* x = X + (size_t)row * D; f32x4 v[8]; float s = 0.f;
#pragma unroll
        for (int j = 0; j < 8; ++j) { v[j] = *(const f32x4*)(x + 4 * (64 * j + F.lane)); s += (v[j][0] + v[j][1]) + (v[j][2] + v[j][3]); }
        const float mean = wave_sum(s, F.lane) * (1.0f / D); float q = 0.f;
#pragma unroll
        for (int j = 0; j < 8; ++j) { v[j] = v[j] - mean; q += (v[j][0] * v[j][0] + v[j][1] * v[j][1]) + (v[j][2] * v[j][2] + v[j][3] * v[j][3]); }
        const float rstd = 1.0f / sqrtf(wave_sum(q, F.lane) * (1.0f / D) + LN_EPS);
        const float* sh = modl ? modl + (size_t)mod_of_row(row) * NMOD + (size_t)shift_idx * D : nullptr; bf16* h = wsb(F, WS_H) + (size_t)row * D;
#pragma unroll
        for (int j = 0; j < 8; ++j) { const int c = 4 * (64 * j + F.lane); f32x4 o = v[j] * rstd * *(const f32x4*)(g + c) + *(const f32x4*)(b + c); if (dummy) o = v[j] + mean; *(f32x4*)(x + c) = o;
            if (sh) { const f32x4 hh = o * (*(const f32x4*)(sh + D + c) + 1.0f) + *(const f32x4*)(sh + c); uint2 w; w.x = pk2(hh[0], hh[1]); w.y = pk2(hh[2], hh[3]); *(uint2*)(h + c) = w; } }
    }
}
typedef short bf16x8 __attribute__((ext_vector_type(8)));
typedef short bf16x4 __attribute__((ext_vector_type(4)));
struct GlaArgs { const bf16* Gq; const bf16* Gk; const bf16* GvT; const float* Glr; const float* wa; const float* ba; const float* s0; float* Of; float* Ob; float* sfin; int L, nb; };
constexpr int GL_P = 272, GL_PT = 144;
constexpr int GL_QT = 0, GL_KT = 17408, GL_QE = 34816, GL_KD = 52224, GL_AT = 70656, GL_TOT = 79872, GL_DEC = 83968, GL_END = 84480;
__device__ __forceinline__ float log_sigmoid_f(float x) { return fminf(x, 0.f) - __logf(1.0f + __expf(-fabsf(x))); }
__device__ __forceinline__ void gla_unit(const Frame& F, const GlaArgs& A, int unit, int layer) {
    const int vs = unit & 1, dir = (unit >> 1) & 1, h = (unit >> 2) & 3, bl = unit >> 4;
    const int L = A.L, NC = L >> 6, lane = F.lane, w = F.wave, g = lane >> 4, r = lane & 15;
    LAS unsigned char* lds = F.lds;
    LAS float* tot = (LAS float*)(lds + GL_TOT); LAS float* dec = (LAS float*)(lds + GL_DEC);
    float wa0[16], wa1[16];
#pragma unroll
    for (int rr = 0; rr < 16; ++rr) { const float2 t = *(const float2*)(A.wa + ((size_t)dir * 16 + rr) * 512 + h * 128 + 2 * lane); wa0[rr] = t.x; wa1[rr] = t.y; }
    const float2 bav = *(const float2*)(A.ba + (size_t)dir * 512 + h * 128 + 2 * lane);
    f32x4 S[8];
    const int vcol = h * 256 + vs * 128 + w * 16 + r;
#pragma unroll
    for (int kt = 0; kt < 8; ++kt) {
        if (A.s0) { const float* sp = A.s0 + ((((size_t)bl * 2 + layer) * 2 + dir) * 4 + h) * (128 * 256) + (size_t)(16 * kt + 4 * g) * 256 + (vcol - h * 256);
            S[kt] = (f32x4){sp[0], sp[256], sp[512], sp[768]}; }
        else S[kt] = (f32x4){0.f, 0.f, 0.f, 0.f};
    }
    float* Od = dir ? A.Ob : A.Of;
    for (int cn = 0; cn < NC; ++cn) {
        const int n = dir ? NC - 1 - cn : cn; const size_t rl0 = (size_t)bl * L + 64 * n;
        const bf16* vp = A.GvT + ((size_t)bl * 1024 + vcol) * L + 64 * n + 8 * g;
        const bf16x8 vf0 = *(const bf16x8*)vp, vf1 = *(const bf16x8*)(vp + 32);
        float la0[8], la1[8]; unsigned qv[8], kv[8];
#pragma unroll
        for (int i = 0; i < 8; ++i) { const size_t row = rl0 + 8 * w + i; const float* lr = A.Glr + row * 32 + dir * 16;
            float x0 = bav.x, x1 = bav.y;
#pragma unroll
            for (int rr = 0; rr < 16; ++rr) { const float lv = lr[rr]; x0 += lv * wa0[rr]; x1 += lv * wa1[rr]; }
            la0[i] = log_sigmoid_f(x0) * 0.0625f; la1[i] = log_sigmoid_f(x1) * 0.0625f;
            qv[i] = *(const unsigned*)(A.Gq + row * 512 + h * 128 + 2 * lane); kv[i] = *(const unsigned*)(A.Gk + row * 512 + h * 128 + 2 * lane); }
        if (!dir) {
#pragma unroll
            for (int i = 1; i < 8; ++i) { la0[i] += la0[i - 1]; la1[i] += la1[i - 1]; }
            tot[w * 128 + 2 * lane] = la0[7]; tot[w * 128 + 2 * lane + 1] = la1[7];
        } else {
#pragma unroll
            for (int i = 6; i >= 0; --i) { la0[i] += la0[i + 1]; la1[i] += la1[i + 1]; }
            tot[w * 128 + 2 * lane] = la0[0]; tot[w * 128 + 2 * lane + 1] = la1[0];
        }
        __syncthreads();
        float off0 = 0.f, off1 = 0.f, all0 = 0.f, all1 = 0.f;
#pragma unroll
        for (int ww = 0; ww < 8; ++ww) { const float t0 = tot[ww * 128 + 2 * lane], t1 = tot[ww * 128 + 2 * lane + 1]; all0 += t0; all1 += t1;
            const bool before = dir ? (ww > w) : (ww < w); if (before) { off0 += t0; off1 += t1; } }
        const float ref0 = 0.5f * all0, ref1 = 0.5f * all1;
        if (w == 0) { dec[2 * lane] = __expf(all0); dec[2 * lane + 1] = __expf(all1); }
        unsigned kd0[4], kd1[4];
#pragma unroll
        for (int i = 0; i < 8; ++i) { const float b0 = la0[i] + off0, b1 = la1[i] + off1;
            const float q0 = __uint_as_float(qv[i] << 16), q1 = __uint_as_float(qv[i] & 0xffff0000u), k0 = __uint_as_float(kv[i] << 16), k1 = __uint_as_float(kv[i] & 0xffff0000u);
            const int ti = 8 * w + i;
            *(LAS unsigned*)(lds + GL_QT + ti * GL_P + 4 * lane) = pk2(q0 * __expf(b0 - ref0), q1 * __expf(b1 - ref1));
            *(LAS unsigned*)(lds + GL_KT + ti * GL_P + 4 * lane) = pk2(k0 * __expf(ref0 - b0), k1 * __expf(ref1 - b1));
            *(LAS unsigned*)(lds + GL_QE + ti * GL_P + 4 * lane) = pk2(q0 * __expf(b0), q1 * __expf(b1));
            const unsigned short e0 = (unsigned short)f2bf(k0 * __expf(all0 - b0)), e1 = (unsigned short)f2bf(k1 * __expf(all1 - b1));
            if (i & 1) { kd0[i >> 1] |= (unsigned)e0 << 16; kd1[i >> 1] |= (unsigned)e1 << 16; } else { kd0[i >> 1] = e0; kd1[i >> 1] = e1; } }
        *(LAS v4u*)(lds + GL_KD + (2 * lane) * GL_PT + 16 * w) = (v4u){kd0[0], kd0[1], kd0[2], kd0[3]};
        *(LAS v4u*)(lds + GL_KD + (2 * lane + 1) * GL_PT + 16 * w) = (v4u){kd1[0], kd1[1], kd1[2], kd1[3]};
        __syncthreads();
        { const int it = w & 3;
#pragma unroll
          for (int ss = 0; ss < 2; ++ss) { const int st = 2 * (w >> 2) + ss; f32x4 c = {0.f, 0.f, 0.f, 0.f};
#pragma unroll
              for (int ks = 0; ks < 4; ++ks) { const bf16x8 a = *(const LAS bf16x8*)(lds + GL_KT + (16 * st + r) * GL_P + 64 * ks + 16 * g);
                  const bf16x8 b = *(const LAS bf16x8*)(lds + GL_QT + (16 * it + r) * GL_P + 64 * ks + 16 * g);
                  c = __builtin_amdgcn_mfma_f32_16x16x32_bf16(a, b, c, 0, 0, 0); }
              const int ig = 16 * it + r, s0 = 16 * st + 4 * g;
#pragma unroll
              for (int q = 0; q < 4; ++q) { const bool keep = dir ? (s0 + q >= ig) : (s0 + q <= ig); if (!keep) c[q] = 0.f; }
              *(LAS u32x2*)(lds + GL_AT + ig * GL_PT + 2 * s0) = (u32x2){pk2(c[0], c[1]), pk2(c[2], c[3])}; } }
        __syncthreads();
        bf16x8 sb[4];
#pragma unroll
        for (int kk = 0; kk < 4; ++kk) { const unsigned p0 = pk2(S[2 * kk][0], S[2 * kk][1]), p1 = pk2(S[2 * kk][2], S[2 * kk][3]), p2 = pk2(S[2 * kk + 1][0], S[2 * kk + 1][1]), p3 = pk2(S[2 * kk + 1][2], S[2 * kk + 1][3]);
            sb[kk] = __builtin_bit_cast(bf16x8, (v4u){p0, p1, p2, p3}); }
#pragma unroll
        for (int it = 0; it < 4; ++it) { f32x4 o = {0.f, 0.f, 0.f, 0.f}; const int i = 16 * it + r;
            { const bf16x8 a0 = *(const LAS bf16x8*)(lds + GL_AT + i * GL_PT + 16 * g), a1 = *(const LAS bf16x8*)(lds + GL_AT + i * GL_PT + 64 + 16 * g);
              o = __builtin_amdgcn_mfma_f32_16x16x32_bf16(a0, vf0, o, 0, 0, 0); o = __builtin_amdgcn_mfma_f32_16x16x32_bf16(a1, vf1, o, 0, 0, 0); }
#pragma unroll
            for (int kk = 0; kk < 4; ++kk) { const u32x2 lo = *(const LAS u32x2*)(lds + GL_QE + i * GL_P + 64 * kk + 8 * g), hi = *(const LAS u32x2*)(lds + GL_QE + i * GL_P + 64 * kk + 32 + 8 * g);
                const bf16x8 a = __builtin_bit_cast(bf16x8, (v4u){lo.x, lo.y, hi.x, hi.y});
                o = __builtin_amdgcn_mfma_f32_16x16x32_bf16(a, sb[kk], o, 0, 0, 0); }
            float* op = Od + (rl0 + 16 * it + 4 * g) * 1024 + vcol;
            op[0] = o[0]; op[1024] = o[1]; op[2048] = o[2]; op[3072] = o[3]; }
#pragma unroll
        for (int kt = 0; kt < 8; ++kt) { const f32x4 dv = *(const LAS f32x4*)(dec + 16 * kt + 4 * g); f32x4 c = S[kt] * dv; const int k = 16 * kt + r;
            const bf16x8 a0 = *(const LAS bf16x8*)(lds + GL_KD + k * GL_PT + 16 * g), a1 = *(const LAS bf16x8*)(lds + GL_KD + k * GL_PT + 64 + 16 * g);
            c = __builtin_amdgcn_mfma_f32_16x16x32_bf16(a0, vf0, c, 0, 0, 0); c = __builtin_amdgcn_mfma_f32_16x16x32_bf16(a1, vf1, c, 0, 0, 0); S[kt] = c; }
        __syncthreads();
    }
    if (A.sfin) {
#pragma unroll
        for (int kt = 0; kt < 8; ++kt) { float* sp = A.sfin + ((((size_t)bl * 2 + layer) * 2 + dir) * 4 + h) * (128 * 256) + (size_t)(16 * kt + 4 * g) * 256 + (vcol - h * 256);
            sp[0] = S[kt][0]; sp[256] = S[kt][1]; sp[512] = S[kt][2]; sp[768] = S[kt][3]; }
    }
}
typedef float f32x16 __attribute__((ext_vector_type(16)));
struct AttnArgs { const bf16* Dq; const bf16* Dk; const bf16* DvT; const bf16* Ck; const bf16* CvT; bf16* Yc; const float* ng; const float* lamp; int layer; int L, nbatch, nqb; };
constexpr int AT_KP = 144, AT_VP = 136, AT_KB = 64 * AT_KP  , AT_VB = 128 * AT_VP  , AT_STAGE = AT_KB + AT_VB;
__device__ __forceinline__ void attn_pass(const Frame& F, const AttnArgs& A, const int j, const int bl, const int h, const size_t qrow, f32x16 (&O)[4], float& lsum) {
    const int L = A.L, lane = F.lane, tid = F.tid, c = lane & 31, h2 = lane >> 5;
    LAS unsigned char* lds = F.lds;
    const int nct = A.Ck ? 4 : 0, ntile = nct + (L >> 6);
    const int kkey = tid >> 3, kpart = tid & 7, vdv0 = tid >> 3, vpart = tid & 7;
    const unsigned koff = (unsigned)(kkey * 1024 + kpart * 8), voff = (unsigned)vdv0 * (unsigned)L + vpart * 8, voffc = (unsigned)(vdv0 * 256 + vpart * 8);
#define AT_ISSUE(t_) do { const int t__ = (t_); \
        if (t__ < nct) { const bf16* kb_ = A.Ck + ((size_t)bl * 256 + 64 * t__) * 1024 + h * 128 + 64 * j; pk0 = *(const v4u*)(kb_ + koff); \
            const bf16* vb_ = A.CvT + ((size_t)bl * 1024 + h * 128) * 256 + 64 * t__; pv0 = *(const v4u*)(vb_ + voffc); pv1 = *(const v4u*)(vb_ + voffc + 64 * 256); } \
        else { const int k0_ = 64 * (t__ - nct); const bf16* kb_ = A.Dk + ((size_t)bl * L + k0_) * 1024 + h * 128 + 64 * j; pk0 = *(const v4u*)(kb_ + koff); \
            const bf16* vb_ = A.DvT + ((size_t)bl * 1024 + h * 128) * L + k0_; pv0 = *(const v4u*)(vb_ + voff); pv1 = *(const v4u*)(vb_ + voff + 64u * (unsigned)L); } } while (0)
#define AT_COMMIT(buf_) do { LAS unsigned char* kb_ = lds + (buf_) * AT_STAGE; LAS unsigned char* vb_ = kb_ + AT_KB; \
        *(LAS v4u*)(kb_ + kkey * AT_KP + kpart * 16) = pk0; \
        *(LAS u32x2*)(vb_ + vdv0 * AT_VP + vpart * 16) = (u32x2){pv0.x, pv0.y}; *(LAS u32x2*)(vb_ + vdv0 * AT_VP + vpart * 16 + 8) = (u32x2){pv0.z, pv0.w}; \
        *(LAS u32x2*)(vb_ + (vdv0 + 64) * AT_VP + vpart * 16) = (u32x2){pv1.x, pv1.y}; *(LAS u32x2*)(vb_ + (vdv0 + 64) * AT_VP + vpart * 16 + 8) = (u32x2){pv1.z, pv1.w}; } while (0)
    v4u pk0, pv0, pv1;
    bf16x8 qf[4];
#pragma unroll
    for (int ks = 0; ks < 4; ++ks) qf[ks] = *(const bf16x8*)(A.Dq + qrow * 1024 + h * 128 + 64 * j + 16 * ks + 8 * h2);
#pragma unroll
    for (int d = 0; d < 4; ++d)
#pragma unroll
        for (int e = 0; e < 16; ++e) O[d][e] = 0.f;
    float mj = -1e30f, lj = 0.f;
    AT_ISSUE(0); AT_COMMIT(0); __syncthreads();
#pragma unroll 1
    for (int t = 0; t < ntile; ++t) {
        const int buf = t & 1;
        if (t + 1 < ntile) AT_ISSUE(t + 1);
        const LAS unsigned char* kb = lds + buf * AT_STAGE; const LAS unsigned char* vb = kb + AT_KB;
        f32x16 s[2];
#pragma unroll
        for (int kt = 0; kt < 2; ++kt) {
#pragma unroll
            for (int e = 0; e < 16; ++e) s[kt][e] = 0.f;
#pragma unroll
            for (int ks = 0; ks < 4; ++ks) { const bf16x8 a = *(const LAS bf16x8*)(kb + (32 * kt + c) * AT_KP + (16 * ks + 8 * h2) * 2);
                s[kt] = __builtin_amdgcn_mfma_f32_32x32x16_bf16(a, qf[ks], s[kt], 0, 0, 0); } }
        float mx = s[0][0];
#pragma unroll
        for (int e = 1; e < 16; ++e) mx = fmaxf(mx, s[0][e]);
#pragma unroll
        for (int e = 0; e < 16; ++e) mx = fmaxf(mx, s[1][e]);
        mx = fmaxf(mx, shflx(mx, 32, lane));
        const float mnew = fmaxf(mj, mx), alpha = __builtin_amdgcn_exp2f(mj - mnew); mj = mnew;
        float ls = 0.f;
#pragma unroll
        for (int kt = 0; kt < 2; ++kt)
#pragma unroll
            for (int e = 0; e < 16; ++e) { const float p = __builtin_amdgcn_exp2f(s[kt][e] - mnew); s[kt][e] = p; ls += p; }
        lj = lj * alpha + ls;
#pragma unroll
        for (int d = 0; d < 4; ++d)
#pragma unroll
            for (int e = 0; e < 16; ++e) O[d][e] *= alpha;
#pragma unroll
        for (int kt = 0; kt < 2; ++kt)
#pragma unroll
            for (int sp = 0; sp < 2; ++sp) {
                const bf16x8 pf = __builtin_bit_cast(bf16x8, (v4u){pk2(s[kt][8 * sp + 0], s[kt][8 * sp + 1]), pk2(s[kt][8 * sp + 2], s[kt][8 * sp + 3]), pk2(s[kt][8 * sp + 4], s[kt][8 * sp + 5]), pk2(s[kt][8 * sp + 6], s[kt][8 * sp + 7])});
#pragma unroll
                for (int d = 0; d < 4; ++d) { const LAS unsigned char* vp = vb + (32 * d + c) * AT_VP + (32 * kt + 16 * sp + 4 * h2) * 2;
                    const u32x2 lo = *(const LAS u32x2*)vp, hi = *(const LAS u32x2*)(vp + 16);
                    const bf16x8 a = __builtin_bit_cast(bf16x8, (v4u){lo.x, lo.y, hi.x, hi.y});
                    O[d] = __builtin_amdgcn_mfma_f32_32x32x16_bf16(a, pf, O[d], 0, 0, 0); } }
        if (t + 1 < ntile) AT_COMMIT(buf ^ 1);
        __syncthreads();
    }
    lsum = lj;
#undef AT_ISSUE
#undef AT_COMMIT
}
__device__ __forceinline__ void attn_unit(const Frame& F, const AttnArgs& A, int unit) {
    const int qb = unit % A.nqb, h = (unit / A.nqb) & 7, bl = unit / (A.nqb * 8);
    const int lane = F.lane, c = lane & 31, h2 = lane >> 5;
    const size_t qrow = (size_t)bl * A.L + 256 * qb + 32 * F.wave + c;
    unsigned Op[4][8];
    { f32x16 O[4]; float l0; attn_pass(F, A, 0, bl, h, qrow, O, l0);
      const float i0 = 1.0f / (l0 + shflx(l0, 32, lane));
#pragma unroll
      for (int d = 0; d < 4; ++d)
#pragma unroll
          for (int e = 0; e < 8; ++e) Op[d][e] = pk2(O[d][2 * e] * i0, O[d][2 * e + 1] * i0); }
    f32x16 O[4]; float l1; attn_pass(F, A, 1, bl, h, qrow, O, l1);
    float lam;
    { const float* lp = A.lamp; float d01 = 0.f, d23 = 0.f;
      for (int i = 0; i < 64; ++i) { d01 += lp[i] * lp[64 + i]; d23 += lp[128 + i] * lp[192 + i]; }
      lam = expf(d01) - expf(d23); }
    int lyr = A.layer; asm volatile("" : "+s"(lyr));
    const float lam_init = lyr == 0 ? 0.2f : 0.8f - 0.6f * 0.7408182206817179f; lam += lam_init;
    const float i1 = lam / (l1 + shflx(l1, 32, lane)); float ss = 0.f;
#pragma unroll
    for (int d = 0; d < 4; ++d)
#pragma unroll
        for (int e = 0; e < 8; ++e) { const float a0 = __uint_as_float(Op[d][e] << 16) - O[d][2 * e] * i1, a1 = __uint_as_float(Op[d][e] & 0xffff0000u) - O[d][2 * e + 1] * i1;
            O[d][2 * e] = a0; O[d][2 * e + 1] = a1; ss += a0 * a0 + a1 * a1; }
    ss += shflx(ss, 32, lane);
    const float rn = (1.0f - lam_init) / sqrtf(ss * (1.0f / 128.0f) + RMS_EPS);
    bf16* yo = A.Yc + qrow * 1024 + h * 128;
#pragma unroll
    for (int d = 0; d < 4; ++d)
#pragma unroll
        for (int rg = 0; rg < 4; ++rg) { const int dv = 32 * d + 8 * rg + 4 * h2; const f32x4 gg = *(const f32x4*)(A.ng + dv);
            u32x2 o; o.x = pk2(O[d][4 * rg + 0] * rn * gg[0], O[d][4 * rg + 1] * rn * gg[1]); o.y = pk2(O[d][4 * rg + 2] * rn * gg[2], O[d][4 * rg + 3] * rn * gg[3]);
            *(u32x2*)(yo + dv) = o; }
}
#ifndef FFT_HOST
typedef float cfl __attribute__((ext_vector_type(2)));
#define FFT_C cfl
#define FFT_MK(a, b) ((cfl){(a), (b)})
#define FFT_PTR LAS cfl*
#define FFT_DEV __device__ __forceinline__
#define FFT_MDEV static __device__ __forceinline__
#else
#define FFT_C float2
#define FFT_MK(a, b) make_float2((a), (b))
#define FFT_PTR FFT_C*
#define FFT_DEV static inline
#define FFT_MDEV static inline
#endif
FFT_DEV int fpad(int p) { return p + (p >> 3); }
FFT_DEV FFT_C cmul(FFT_C a, FFT_C b) { return FFT_MK(a.x * b.x - a.y * b.y, a.x * b.y + a.y * b.x); }
template <int M16> FFT_DEV FFT_C mul_w16(FFT_C d) {
    constexpr float C1 = 0.92387953251128674f, S1 = 0.38268343236508977f, H = 0.70710678118654752f;
    if (M16 == 0) return d;
    if (M16 == 4) return FFT_MK(d.y, -d.x);
    constexpr float wr = M16 == 1 ? C1 : M16 == 2 ? H : M16 == 3 ? S1 : M16 == 5 ? -S1 : M16 == 6 ? -H : -C1;
    constexpr float wi = M16 == 1 ? -S1 : M16 == 2 ? -H : M16 == 3 ? -C1 : M16 == 5 ? -C1 : M16 == 6 ? -H : -S1;
    return FFT_MK(d.x * wr - d.y * wi, d.x * wi + d.y * wr);
}
template <int R, int HALF, int G0, int T> struct DifStep {
    FFT_MDEV void run(FFT_C (&x)[R]) {
        const FFT_C a = x[G0 + T], b = x[G0 + T + HALF];
        x[G0 + T] = FFT_MK(a.x + b.x, a.y + b.y);
        x[G0 + T + HALF] = mul_w16<(T * 8) / HALF>(FFT_MK(a.x - b.x, a.y - b.y));
        if constexpr (T + 1 < HALF) DifStep<R, HALF, G0, T + 1>::run(x);
        else if constexpr (G0 + 2 * HALF < R) DifStep<R, HALF, G0 + 2 * HALF, 0>::run(x);
        else if constexpr (HALF > 1) DifStep<R, HALF / 2, 0, 0>::run(x);
    }
};
template <int R> FFT_DEV void dft_fwd(FFT_C (&x)[R]) { DifStep<R, R / 2, 0, 0>::run(x); }
template <int R> FFT_DEV constexpr int brev(int i) { int r = 0; for (int b = 1; b < R; b <<= 1) { r = (r << 1) | (i & 1); i >>= 1; } return r; }
template <int R, int Q, int K1> struct StoreFwd {
    FFT_MDEV void run(FFT_PTR buf, int base, const FFT_C (&x)[R], FFT_C w, FFT_C w1) {
        constexpr int i = brev<R>(K1);
        buf[fpad(base + K1 * Q)] = (Q > 1 && K1 > 0) ? cmul(x[i], w) : x[i];
        if constexpr (K1 + 1 < R) StoreFwd<R, Q, K1 + 1>::run(buf, base, x, Q > 1 ? cmul(w, w1) : w, w1);
    }
};
template <int R, int Q, int K> struct TwInv {
    FFT_MDEV void run(FFT_C (&x)[R], FFT_C w, FFT_C w1) {
        const FFT_C c = FFT_MK(x[K].x, -x[K].y); x[K] = (Q > 1 && K > 0) ? cmul(c, w) : c;
        if constexpr (K + 1 < R) TwInv<R, Q, K + 1>::run(x, Q > 1 ? cmul(w, w1) : w, w1);
    }
};
template <int R, int Q, int I> struct StoreInv {
    FFT_MDEV void run(FFT_PTR buf, int base, const FFT_C (&x)[R]) {
        constexpr int j = brev<R>(I);
        buf[fpad(base + j * Q)] = FFT_MK(x[I].x, -x[I].y);
        if constexpr (I + 1 < R) StoreInv<R, Q, I + 1>::run(buf, base, x);
    }
};
template <int R, int J> struct LoadX {
    FFT_MDEV void run(FFT_PTR buf, int base, int q, FFT_C (&x)[R]) { x[J] = buf[fpad(base + J * q)]; if constexpr (J + 1 < R) LoadX<R, J + 1>::run(buf, base, q, x); }
};
template <int R, int K1> struct StoreFwdRt {
    FFT_MDEV void run(FFT_PTR buf, int base, int q, const FFT_C (&x)[R], FFT_C w, FFT_C w1) {
        constexpr int i = brev<R>(K1);
        buf[fpad(base + K1 * q)] = (K1 > 0) ? cmul(x[i], w) : x[i];
        if constexpr (K1 + 1 < R) StoreFwdRt<R, K1 + 1>::run(buf, base, q, x, cmul(w, w1), w1);
    }
};
template <int R, int I> struct StoreInvRt {
    FFT_MDEV void run(FFT_PTR buf, int base, int q, const FFT_C (&x)[R]) {
        constexpr int j = brev<R>(I);
        buf[fpad(base + j * q)] = FFT_MK(x[I].x, -x[I].y);
        if constexpr (I + 1 < R) StoreInvRt<R, I + 1>::run(buf, base, q, x);
    }
};
FFT_DEV FFT_C tw_of(const FFT_C* tw, int idx) {
#ifndef FFT_HOST
    const float f = (float)idx * (1.0f / 8192.0f); (void)tw; return FFT_MK(__builtin_amdgcn_cosf(f), -__builtin_amdgcn_sinf(f));
#else
    return tw[idx];
#endif
}
template <int R, bool INV> FFT_DEV void fft_pass_rt(FFT_PTR buf, const FFT_C* tw, int tid, int lq, int ltw  ) {
    constexpr int NB = 8192 / R, PER = NB / 512;
    const int q = 1 << lq;
#pragma unroll 1
    for (int u = 0; u < PER; ++u) {
        const int beta = tid + u * 512, blk = beta >> lq, np = beta & (q - 1), base = ((blk * R) << lq) + np;
        FFT_C x[R];
        LoadX<R, 0>::run(buf, base, q, x);
        const FFT_C w1 = tw_of(tw, np << ltw);
        if (!INV) { dft_fwd<R>(x); StoreFwdRt<R, 0>::run(buf, base, q, x, FFT_MK(1.f, 0.f), w1); }
        else { TwInv<R, 2, 0>::run(x, FFT_MK(1.f, 0.f), w1); dft_fwd<R>(x); StoreInvRt<R, 0>::run(buf, base, q, x); }
    }
}
constexpr int FFT_BUFB = 73728;
struct HyArgs { const bf16* ZhT; bf16* YaT; const float* filt; const cfl* spec; const float* cw; const float* cb; const float* hbias; int L, nb; };
__device__ __forceinline__ void fft_fwd_n(LAS cfl* bA, const cfl* tw, int tid, int nbuf) {
#pragma unroll 1
    for (int bs = 0; bs < nbuf; ++bs) fft_pass_rt<16, false>(bA + bs * (FFT_BUFB / 8), tw, tid, 9, 0);
    __syncthreads();
#pragma unroll 1
    for (int p = 0; p < 3; ++p) {
#pragma unroll 1
        for (int bs = 0; bs < nbuf; ++bs) fft_pass_rt<8, false>(bA + bs * (FFT_BUFB / 8), tw, tid, 6 - 3 * p, 4 + 3 * p);
        __syncthreads();
    }
}
__device__ __forceinline__ void fft_inv_n(LAS cfl* bA, const cfl* tw, int tid, int nbuf) {
#pragma unroll 1
    for (int p = 2; p >= 0; --p) {
#pragma unroll 1
        for (int bs = 0; bs < nbuf; ++bs) fft_pass_rt<8, true>(bA + bs * (FFT_BUFB / 8), tw, tid, 6 - 3 * p, 4 + 3 * p);
        __syncthreads(); }
#pragma unroll 1
    for (int bs = 0; bs < nbuf; ++bs) fft_pass_rt<16, true>(bA + bs * (FFT_BUFB / 8), tw, tid, 9, 0);
    __syncthreads();
}
__device__ __forceinline__ void shortconv8(const bf16* zrow, int t0, int L, float w0, float w1, float w2, float b, float (&out)[8]) {
    const v4u zc = *(const v4u*)(zrow + t0);
    float z[10];
    z[0] = t0 > 0 ? bf2f(zrow[t0 - 1]) : 0.f; z[9] = t0 + 8 < L ? bf2f(zrow[t0 + 8]) : 0.f;
    z[1] = __uint_as_float(zc.x << 16); z[2] = __uint_as_float(zc.x & 0xffff0000u); z[3] = __uint_as_float(zc.y << 16); z[4] = __uint_as_float(zc.y & 0xffff0000u);
    z[5] = __uint_as_float(zc.z << 16); z[6] = __uint_as_float(zc.z & 0xffff0000u); z[7] = __uint_as_float(zc.w << 16); z[8] = __uint_as_float(zc.w & 0xffff0000u);
#pragma unroll
    for (int i = 0; i < 8; ++i) out[i] = w0 * z[i] + w1 * z[i + 1] + w2 * z[i + 2] + b;
}
__device__ __forceinline__ void spec_unit(const Frame& F, int unit) {
    constexpr int L = 4096; const int tid = F.tid, t0 = 8 * tid, ord = unit >> 10, c = unit & 1023;
    LAS cfl* bA = (LAS cfl*)(F.lds);
    float zf = 0.f; asm volatile("" : "+v"(zf));
    const float* hf = wsf(F, WS_FILTL) + ((size_t)(ord * 2 + 0) * 1024 + c) * L; const float* hb = wsf(F, WS_FILTL) + ((size_t)(ord * 2 + 1) * 1024 + c) * L;
    { const f32x4 f0 = *(const f32x4*)(hf + t0), f1 = *(const f32x4*)(hf + t0 + 4), g0 = *(const f32x4*)(hb + t0), g1 = *(const f32x4*)(hb + t0 + 4);
#pragma unroll
      for (int i = 0; i < 8; ++i) { const int j = t0 + i; const float fv = i < 4 ? f0[i] : f1[i - 4], gv = i < 4 ? g0[i] : g1[i - 4];
          bA[fpad(j)] = FFT_MK(fv, zf);
          if (j > 0) bA[fpad(2 * L - j)] = FFT_MK(gv, zf); else bA[fpad(L)] = FFT_MK(zf, zf); } }
    __syncthreads();
    fft_fwd_n(bA, nullptr, tid, 1);
    cfl* sp = (cfl*)(F.ws + WS_SPEC) + (size_t)unit * 9216;
#pragma unroll 2
    for (int i = 0; i < 18; ++i) sp[tid + 512 * i] = bA[tid + 512 * i];
    __syncthreads();
}
__device__ __forceinline__ void hyena_lat_unit(const Frame& F, const HyArgs& A, int unit, cfl* zsc) {
    constexpr int L = 4096; const int tid = F.tid; int t0 = 8 * tid;
#define HY_OPAQUE() asm volatile("" : "+v"(t0))
    LAS cfl* bA = (LAS cfl*)(F.lds);
    float zf = 0.f; asm volatile("" : "+v"(zf));
#pragma unroll 1
    for (int cs = 0; cs < 2; ++cs) { const int c = 2 * unit + cs; LAS cfl* bb = bA + cs * (FFT_BUFB / 8);
      const bf16* z0 = A.ZhT + (size_t)c * L; const bf16* z1 = A.ZhT + ((size_t)3072 + c) * L;
      const float w0 = A.cw[c], w1 = A.cw[3072 + c], w2 = A.cw[6144 + c], b = A.cb[c]; float va[8], vb[8];
      shortconv8(z0, t0, L, w0, w1, w2, b, va); shortconv8(z1, t0, L, w0, w1, w2, b, vb);
#pragma unroll
      for (int i = 0; i < 8; ++i) { bb[fpad(t0 + i)] = FFT_MK(va[i], vb[i]); bb[fpad(t0 + i + L)] = FFT_MK(zf, zf); } }
    __syncthreads();
#pragma unroll 1
    for (int ord = 0; ord < 2; ++ord) {
        fft_fwd_n(bA, nullptr, tid, 2);
#pragma unroll 1
        for (int cs = 0; cs < 2; ++cs) { LAS cfl* bb = bA + cs * (FFT_BUFB / 8); const cfl* sp = A.spec + ((size_t)ord * 1024 + 2 * unit + cs) * 9216;
#pragma unroll 3
            for (int i = 0; i < 18; ++i) { const int p = tid + 512 * i; bb[p] = cmul(bb[p], sp[p]); } }
        __syncthreads();
        fft_inv_n(bA, nullptr, tid, 2);
#pragma unroll 1
        for (int cs = 0; cs < 2; ++cs) { const int c = 2 * unit + cs; LAS cfl* bb = bA + cs * (FFT_BUFB / 8); cfl* zs = zsc + cs * L;
            const bf16* z0 = A.ZhT + (size_t)c * L; const bf16* z1 = A.ZhT + ((size_t)3072 + c) * L;
            HY_OPAQUE();
            const float bias = A.hbias[ord * 1024 + c]; const int col = (ord + 1) * 1024 + c;
            float ga[8], gb[8], ia[8], ib[8];
            { const float w0 = A.cw[col], w1 = A.cw[3072 + col], w2 = A.cw[6144 + col], b = A.cb[col];
              shortconv8(z0 + (size_t)(ord + 1) * 1024 * L, t0, L, w0, w1, w2, b, ga); shortconv8(z1 + (size_t)(ord + 1) * 1024 * L, t0, L, w0, w1, w2, b, gb); }
            if (ord == 0) { const float w0 = A.cw[c], w1 = A.cw[3072 + c], w2 = A.cw[6144 + c], b = A.cb[c]; shortconv8(z0, t0, L, w0, w1, w2, b, ia); shortconv8(z1, t0, L, w0, w1, w2, b, ib); }
            else {
#pragma unroll
                for (int i = 0; i < 4; ++i) { const f32x4 zz = *(const f32x4*)((const float*)(zs + t0) + 4 * i); ia[2 * i] = zz[0]; ib[2 * i] = zz[1]; ia[2 * i + 1] = zz[2]; ib[2 * i + 1] = zz[3]; } }
            float oa[8], ob[8];
#pragma unroll
            for (int i = 0; i < 8; ++i) { const cfl y = bb[fpad(t0 + i)]; oa[i] = ga[i] * (y.x * (1.0f / 8192.0f) + ia[i] * bias); ob[i] = gb[i] * (y.y * (1.0f / 8192.0f) + ib[i] * bias); }
            if (ord == 0) {
#pragma unroll
                for (int i = 0; i < 4; ++i) *(f32x4*)((float*)(zs + t0) + 4 * i) = (f32x4){oa[2 * i], ob[2 * i], oa[2 * i + 1], ob[2 * i + 1]};
#pragma unroll
                for (int i = 0; i < 8; ++i) { bb[fpad(t0 + i)] = FFT_MK(oa[i], ob[i]); bb[fpad(t0 + i + L)] = FFT_MK(zf, zf); }
            } else {
                *(v4u*)(A.YaT + (size_t)c * L + t0) = (v4u){pk2(oa[0], oa[1]), pk2(oa[2], oa[3]), pk2(oa[4], oa[5]), pk2(oa[6], oa[7])};
                *(v4u*)(A.YaT + ((size_t)1024 + c) * L + t0) = (v4u){pk2(ob[0], ob[1]), pk2(ob[2], ob[3]), pk2(ob[4], ob[5]), pk2(ob[6], ob[7])};
            } }
        __syncthreads();
    }
#undef HY_OPAQUE
}
__device__ __forceinline__ float shortconv(const bf16* zrow, int t, int L, float w0, float w1, float w2, float b) {
    const float zm = t > 0 ? bf2f(zrow[t - 1]) : 0.f, z0 = bf2f(zrow[t]), zp = t + 1 < L ? bf2f(zrow[t + 1]) : 0.f;
    return w0 * zm + w1 * z0 + w2 * zp + b;
}
__device__ __forceinline__ void hyena_ctx_unit(const Frame& F, const HyArgs& A, int unit) {
    constexpr int L = 256; const int tid = F.tid, t = tid & 255, hs = tid >> 8, b = unit >> 9, c = (unit & 511) * 2 + hs;
    LAS float* sv = (LAS float*)(F.lds) + hs * 256;
    LAS float* sf = (LAS float*)(F.lds + 2048) + hs * 512;
    float cw[3][3], cbv[3];
#pragma unroll
    for (int s = 0; s < 3; ++s) { const int col = s * 1024 + c; cbv[s] = A.cb[col];
#pragma unroll
        for (int k = 0; k < 3; ++k) cw[s][k] = A.cw[k * 3072 + col]; }
    const bf16* z0 = A.ZhT + ((size_t)b * 3072 + c) * L;
    float in = shortconv(z0, t, L, cw[0][0], cw[0][1], cw[0][2], cbv[0]);
#pragma unroll 1
    for (int ord = 0; ord < 2; ++ord) {
        sv[t] = in; sf[t] = A.filt[((size_t)(ord * 2 + 0) * 1024 + c) * L + t];
        sf[(512 - t) & 511] = t ? A.filt[((size_t)(ord * 2 + 1) * 1024 + c) * L + t] : sf[0];
        if (t == 0) sf[256] = 0.f;
        __syncthreads();
        float y = 0.f;
#pragma unroll 1
        for (int s0 = 0; s0 < L; s0 += 8) {
            const f32x4 va = *(const LAS f32x4*)(sv + s0), vb = *(const LAS f32x4*)(sv + s0 + 4);
            float tp[8];
#pragma unroll
            for (int i = 0; i < 8; ++i) tp[i] = sf[(t - s0 - i) & 511];
            y += tp[0] * va[0]; y += tp[1] * va[1]; y += tp[2] * va[2]; y += tp[3] * va[3]; y += tp[4] * vb[0]; y += tp[5] * vb[1]; y += tp[6] * vb[2]; y += tp[7] * vb[3];
        }
        const float g = ord == 0 ? shortconv(z0 + (size_t)1024 * L, t, L, cw[1][0], cw[1][1], cw[1][2], cbv[1]) : shortconv(z0 + (size_t)2048 * L, t, L, cw[2][0], cw[2][1], cw[2][2], cbv[2]);
        in = g * (y + in * A.hbias[ord * 1024 + c]);
        __syncthreads();
    }
    A.YaT[((size_t)b * 1024 + c) * L + t] = f2b(in);
}
__device__ __forceinline__ void filt_item(const Frame& F, int layer, int item) {
    const int ls = item < 1024 ? 1 : 0, r = ls ? item : item - 1024, cb = ls ? (r >> 4) : r, jb = ls ? (r & 15) : 0, L = ls ? 4096 : 256;
    LAS float* sh = (LAS float*)(F.lds);
    LAS float* sw = (LAS float*)(F.lds + 256 * 65 * 4);
    const float* hd = wsf(F, WS_HDN) + (((size_t)layer * 2 + ls) * 4096 + jb * 256) * FH;
    for (int i = F.tid; i < 256 * 64; i += 512) sh[(i >> 6) * 65 + (i & 63)] = hd[i];
    const float* w3 = F.in[I_HW3] + (size_t)layer * FH * 4096 + cb * 64;
    for (int i = F.tid; i < 64 * 64; i += 512) sw[i] = w3[(size_t)(i >> 6) * 4096 + (i & 63)];
    __syncthreads();
    const int j = F.tid & 255, c0 = (F.tid >> 8) * 32; float acc[32];
#pragma unroll
    for (int q = 0; q < 32; ++q) acc[q] = 0.f;
    for (int m = 0; m < 64; ++m) { const float hv = sh[j * 65 + m];
#pragma unroll
        for (int q = 0; q < 32; ++q) acc[q] += hv * sw[m * 64 + c0 + q]; }
    const float tj = (float)(jb * 256 + j) / (float)(L - 1);
    float* out = ls ? wsf(F, WS_FILTL) : wsf(F, WS_FILTC);
#pragma unroll
    for (int q = 0; q < 32; ++q) { const int col = cb * 64 + c0 + q; const float dc = fabsf(F.in[I_HDEC][(size_t)layer * 4096 + col]);
        out[(size_t)col * L + jb * 256 + j] = acc[q] * __expf(-tj * dc); }
    __syncthreads();
}
struct FinArgs { const float* Of; const float* Ob; const bf16* Gr; const float* gn; bf16* Yb; const bf16* YaT; bf16* Ya; int nr, L, lshift; };
__device__ __forceinline__ void fin_phase(const Frame& F, const FinArgs& A) {
    for (int row = F.gw; row < A.nr; row += F.NGW) {
#pragma unroll
        for (int hh = 0; hh < 4; ++hh) { const size_t o = (size_t)row * 1024 + hh * 256 + 4 * F.lane; const f32x4 v = *(const f32x4*)(A.Of + o) + *(const f32x4*)(A.Ob + o);
            const float ss = wave_sum((v[0] * v[0] + v[1] * v[1]) + (v[2] * v[2] + v[3] * v[3]), F.lane); const float rn = 1.0f / sqrtf(ss * (1.0f / 256.0f) + RMS_EPS);
            const f32x4 g = *(const f32x4*)(A.gn + 4 * F.lane); const u32x2 gr = *(const u32x2*)(A.Gr + o);
            const float r0 = __uint_as_float(gr.x << 16), r1 = __uint_as_float(gr.x & 0xffff0000u), r2 = __uint_as_float(gr.y << 16), r3 = __uint_as_float(gr.y & 0xffff0000u);
            u32x2 w; w.x = pk2(v[0] * rn * g[0] * r0, v[1] * rn * g[1] * r1); w.y = pk2(v[2] * rn * g[2] * r2, v[3] * rn * g[3] * r3); *(u32x2*)(A.Yb + o) = w; }
    }
    LAS bf16* sc = (LAS bf16*)(F.lds + F.wave * 16384);
    const int nit = (A.nr >> 6) * 16;
    for (int it = F.gw; it < nit; it += F.NGW) { const int rb = it >> 4, cb = it & 15, r0 = rb * 64, b = r0 >> A.lshift, t0 = r0 & (A.L - 1);
        for (int cc = 0; cc < 64; ++cc) sc[cc * 66 + F.lane] = A.YaT[((size_t)b * 1024 + cb * 64 + cc) * A.L + t0 + F.lane];
        LDS_WAIT(); asm volatile("" ::: "memory");
        for (int rr = 0; rr < 64; ++rr) A.Ya[(size_t)(r0 + rr) * 1024 + cb * 64 + F.lane] = sc[F.lane * 66 + rr];
        LDS_WAIT(); asm volatile("" ::: "memory"); }
}
struct Chunk { int r0, nr, L, lshift, nb, b0; bool lat; };
__device__ __forceinline__ Chunk chunk_of(int ch) { Chunk c; if (ch == 0) { c.r0 = 0; c.nr = RCTX; c.L = LCTX; c.lshift = 8; c.nb = NCTXB; c.b0 = 0; c.lat = false; }
    else { c.r0 = RCTX + (ch - 1) * 8192; c.nr = 8192; c.L = LLAT; c.lshift = 12; c.nb = 2; c.b0 = 2 * (ch - 1); c.lat = true; } return c; }
constexpr int CW_QUEUE = 8192;
#ifndef REP_GLA
#define REP_GLA 1
#endif
#ifndef REP_ATT
#define REP_ATT 1
#endif
#ifndef REP_HY
#define REP_HY 1
#endif
#ifndef REP_WIN
#define REP_WIN 1
#endif
#ifndef REP_UP
#define REP_UP 1
#endif
#ifndef REP_BR
#define REP_BR 1
#endif
#ifndef REP_FIN
#define REP_FIN 1
#endif
__device__ __forceinline__ void grid_bar(int wv) {
    const Frame F = make_frame(wv);
    XcdBarrier b; b.bar = (unsigned*)(F.ctl + CW_BAR); b.x = xb_xcc_id(); b.st = F.MISC + 8;
    xcd_barrier(b);
}
#ifndef REP_PRO
#define REP_PRO 1
#endif
#ifndef REP_DOWN
#define REP_DOWN 1
#endif
#ifndef REP_WOUT
#define REP_WOUT 1
#endif
#ifndef REP_LN
#define REP_LN 1
#endif
#ifndef REP_BAR
#define REP_BAR 1
#endif
#ifndef STAG_TAU
#define STAG_TAU 400
#endif
__device__ __forceinline__ void stagger_start() {
    const unsigned long long t0 = __builtin_amdgcn_s_memrealtime(), tgt = t0 + (unsigned long long)(((blockIdx.x >> 3) & 7u) * STAG_TAU);
    while (__builtin_amdgcn_s_memrealtime() < tgt) __builtin_amdgcn_s_sleep(8);
}
#define GRID_BAR() do { for (int rb_ = 0; rb_ < REP_BAR; ++rb_) grid_bar(wv); } while (0)

__global__ void __launch_bounds__(NWAVES * 64, 2) fwd_kernel(Args args) {
    int wv = __builtin_amdgcn_readfirstlane((int)threadIdx.x >> 6); asm volatile("" : "+s"(wv));
    {   const Frame F = make_frame(wv);
        for (int u = F.tid; u < (LDS_BYTES - LDSCTL_OFF) / 4; u += NWAVES * 64) ((LAS unsigned*)(F.lds + LDSCTL_OFF))[u] = 0u;
        __syncthreads();
        (void)xcd_barrier_post((unsigned*)(F.ctl + CW_BAR), F.MISC + 8);
        for (int rp_ = 0; rp_ < REP_PRO; ++rp_) p0_prologue(F); }
    GRID_BAR();
    {   const Frame F = make_frame(wv); p0_h0(F); }

#pragma unroll 1
    for (int l = 0; l < DEPTH; ++l) {
        { const Frame F = make_frame(wv); for (int it = blockIdx.x; it < 1088; it += F.G) filt_item(F, l, it); }
        GRID_BAR();
        { const Frame F = make_frame(wv); for (int u = blockIdx.x; u < 2048; u += F.G) spec_unit(F, u); }
        GRID_BAR();
#pragma unroll 1
        for (int s = 0; s < 3; ++s) {
            if (s != 1) {
                const int fi = s >> 1;
                for (int rep = 0; rep < REP_UP; ++rep) { const Frame F = make_frame(wv); unsigned char* wl = F.ws + WS_W + (size_t)l * WL_STRIDE;
                  pg8::Gemm g{(const pg8::bf16_t*)wsb(F, WS_H), (const pg8::bf16_t*)(wl + WL_W13) + (size_t)fi * 11008 * D, MTOT, 11008, D};
                  pg8::StaticOrder S; S.init(MTOT, 11008, F.G, (int)blockIdx.x);
                  pg8::EpiSwiglu E{(pg8::bf16_t*)wsb(F, WS_U), FF};
                  pg8::gemm_phase<pg8::EpiSwiglu, pg8::StaticOrder, true, true>(F.lds + RING_OFF, g, S, E, F.tid); }
                GRID_BAR();
                for (int rep = 0; rep < REP_DOWN; ++rep) { const Frame F = make_frame(wv); unsigned char* wl = F.ws + WS_W + (size_t)l * WL_STRIDE; float* X = F.out;
                  const float* modl = wsf(F, WS_MOD) + (size_t)l * 9 * NMOD;
                  pg8::Gemm g{(const pg8::bf16_t*)wsb(F, WS_U), (const pg8::bf16_t*)(wl + WL_W2) + (size_t)fi * D * FF, MTOT, D, FF, 1, 0};
                  pg8::StaticOrder S; S.init(MTOT, D, F.G, (int)blockIdx.x);
                  const bool first = (l == 0 && s == 0);
                  const bool dummy = rep + 1 < REP_DOWN;
                  pg8::EpiResid E{(first && !dummy) ? F.in[I_XP] : X, (first && !dummy) ? F.in[I_XS] : X + (size_t)RCTX * D, X, modl + (size_t)(s == 0 ? 2 : 8) * D, 0, dummy ? 0.f : 0.5f, dummy ? 1.f : ALPHA};
                  pg8::gemm_phase<pg8::EpiResid, pg8::StaticOrder, true, true>(F.lds + RING_OFF, g, S, E, F.tid); }
                GRID_BAR();
            } else {
#pragma unroll 1
                for (int k = 0; k <= NCHUNK; ++k) {
                    if (k >= 1) { const int ch = k - 1;
                      for (int rep = 0; rep < REP_WOUT; ++rep) { const Frame F = make_frame(wv); const Chunk C = chunk_of(ch); unsigned char* wl = F.ws + WS_W + (size_t)l * WL_STRIDE; float* X = F.out;
                        const float* modl = wsf(F, WS_MOD) + (size_t)l * 9 * NMOD; const bool dummy = rep + 1 < REP_WOUT;
                        pg8::Gemm g{(const pg8::bf16_t*)wsb(F, MX_Y16), (const pg8::bf16_t*)(wl + WL_WO), C.nr, D, D};
                        pg8::StaticOrder S; S.init(C.nr, D, F.G, (int)blockIdx.x);
                        pg8::EpiResid E{X, X + (size_t)RCTX * D, X, modl + (size_t)5 * D, C.r0 / 256, dummy ? 0.f : 1.0f, dummy ? 1.f : ALPHA};
                        pg8::gemm_phase<pg8::EpiResid, pg8::StaticOrder, true, true>(F.lds + RING_OFF, g, S, E, F.tid); } }
                    if (k < NCHUNK) { const int ch = k;
                      for (int rep = 0; rep < REP_WIN; ++rep) { const Frame F = make_frame(wv); const Chunk C = chunk_of(ch); unsigned char* wl = F.ws + WS_W + (size_t)l * WL_STRIDE;
                        pg8::Gemm g{(const pg8::bf16_t*)wsb(F, WS_H) + (size_t)C.r0 * D, (const pg8::bf16_t*)(wl + WL_WIN), C.nr, INP, D};
                        pg8::StaticOrder S; S.init(C.nr, INP, F.G, (int)blockIdx.x);
                        pg8::EpiWin E{F.ws, C.lat ? nullptr : F.out + O_NCK + (size_t)l * 256 * 1024, C.lat ? nullptr : F.out + O_NCV + (size_t)l * 256 * 1024, C.L, C.lshift};
                        pg8::gemm_phase<pg8::EpiWin, pg8::StaticOrder, true, true>(F.lds + RING_OFF, g, S, E, F.tid); } }
                    GRID_BAR();
                    if (k == NCHUNK) break;
                    const int ch = k;
#define QUEUE_LOOP(qi_, n_, grain_, body_) do { gu32* head_ = F.ctl + CW_QUEUE + 64 * (((rep * 2 + l) * NCHUNK + ch) * 4 + (qi_)); const int n__ = (n_); \
        for (;;) { if (F.tid == 0) F.MISC[16] = __hip_atomic_fetch_add(head_, (unsigned)(grain_), __ATOMIC_RELAXED, __HIP_MEMORY_SCOPE_AGENT); \
            __syncthreads(); const int u0_ = __builtin_amdgcn_readfirstlane((int)F.MISC[16]); __syncthreads(); if (u0_ >= n__) break; \
            for (int u = u0_; u < u0_ + (grain_) && u < n__; ++u) { body_; } } } while (0)
                    for (int rep = 0; rep < REP_GLA; ++rep) { const Frame F = make_frame(wv); const Chunk C = chunk_of(ch);
                      GlaArgs GA{wsb(F, MX_GQ), wsb(F, MX_GK), wsb(F, MX_GVT), wsf(F, MX_GLR), F.in[I_GWA] + (size_t)l * 2 * 16 * 512, F.in[I_GBA] + (size_t)l * 2 * 512,
                                 C.lat ? F.in[I_SG] + (size_t)C.b0 * (2 * 2 * 4 * 128 * 256) : nullptr, wsf(F, MX_OF), wsf(F, MX_OB), C.lat ? nullptr : F.out + O_NSG, C.L, C.nb};
                      QUEUE_LOOP(0, C.nb * 16, 1, gla_unit(F, GA, u, l)); }
                    for (int rep = 0; rep < REP_ATT; ++rep) { const Frame F = make_frame(wv); const Chunk C = chunk_of(ch);
                      AttnArgs AA{wsb(F, MX_DQ), wsb(F, MX_DK), wsb(F, MX_DVT), C.lat ? wsb(F, WS_CKB) + ((size_t)l * 8 + C.b0) * 256 * 1024 : nullptr,
                                  C.lat ? wsb(F, WS_CVT) + ((size_t)l * 8 + C.b0) * 1024 * 256 : nullptr, wsb(F, MX_YC), F.in[I_DNG] + (size_t)l * 128, F.in[I_DLAM] + (size_t)l * 4 * 64,
                                  l, C.L, C.nb, C.lat ? 16 : 1};
                      QUEUE_LOOP(1, C.lat ? C.nb * 8 * 16 : C.nb * 8, 1, attn_unit(F, AA, u)); }
                    for (int rep = 0; rep < REP_HY; ++rep) if (ch != 0) { const Frame F = make_frame(wv);
                      HyArgs HA{wsb(F, MX_ZHT), wsb(F, MX_YAT), nullptr, (const cfl*)(F.ws + WS_SPEC), F.in[I_HCW] + (size_t)l * 3 * 3072, F.in[I_HCB] + (size_t)l * 3072,
                                F.in[I_HBIAS] + (size_t)l * 2 * 1024, LLAT, 2};
                      QUEUE_LOOP(2, 512, 1, hyena_lat_unit(F, HA, u, (cfl*)(F.ws + MX_Y16) + (size_t)blockIdx.x * 8192)); }
                    else { const Frame F = make_frame(wv);
                      HyArgs HA{wsb(F, MX_ZHT), wsb(F, MX_YAT), wsf(F, WS_FILTC), nullptr, F.in[I_HCW] + (size_t)l * 3 * 3072, F.in[I_HCB] + (size_t)l * 3072,
                                F.in[I_HBIAS] + (size_t)l * 2 * 1024, LCTX, NCTXB};
                      QUEUE_LOOP(3, NCTXB * 512, 8, hyena_ctx_unit(F, HA, u)); }
                    GRID_BAR();
                    for (int rep = 0; rep < REP_FIN; ++rep) { const Frame F = make_frame(wv); const Chunk C = chunk_of(ch);
                      FinArgs FA{wsf(F, MX_OF), wsf(F, MX_OB), wsb(F, MX_GR), F.in[I_GNG] + (size_t)l * 256, wsb(F, MX_YB), wsb(F, MX_YAT), wsb(F, MX_YA), C.nr, C.L, C.lshift};
                      fin_phase(F, FA); }
                    GRID_BAR();
#pragma unroll 1
                    for (int br = 0; br < 3 * REP_BR; ++br) {
                        { const Frame F = make_frame(wv); const Chunk C = chunk_of(ch); unsigned char* wl = F.ws + WS_W + (size_t)l * WL_STRIDE;
                          pg8::Gemm g{(const pg8::bf16_t*)wsb(F, br % 3 == 0 ? MX_YA : br % 3 == 1 ? MX_YB : MX_YC), (const pg8::bf16_t*)(wl + WL_WA + (size_t)(br % 3) * 4 * MiB), C.nr, D, 1024};
                          pg8::StaticOrder S; S.init(C.nr, D, F.G, (int)blockIdx.x);
                          pg8::EpiBranch E{(const pg8::bf16_t*)wsb(F, MX_GT), (br % 3) * D, wsf(F, MX_YACC), (pg8::bf16_t*)wsb(F, MX_Y16), br % 3};
                          pg8::gemm_phase<pg8::EpiBranch, pg8::StaticOrder, true, true>(F.lds + RING_OFF, g, S, E, F.tid); }
                        __builtin_amdgcn_fence(__ATOMIC_ACQUIRE, "agent"); asm volatile("s_waitcnt vmcnt(0)" ::: "memory");
                    }
                    GRID_BAR();
                }
            }
            for (int rep = 0; rep < REP_LN; ++rep) { const Frame F = make_frame(wv); const float* modb = wsf(F, WS_MOD);
              const bool last = (l == DEPTH - 1 && s == 2);
              const float* nm = last ? nullptr : modb + (size_t)(s == 2 ? l + 1 : l) * 9 * NMOD;
              ln_phase(F, F.in[I_LNG] + ((size_t)l * 3 + s) * D, F.in[I_LNB] + ((size_t)l * 3 + s) * D, nm, s == 0 ? 3 : s == 1 ? 6 : 0, rep + 1 < REP_LN); }
            if (!(l == DEPTH - 1 && s == 2)) GRID_BAR();
        }
    }
}
extern "C" void kernel_launch(void* const* d_in, const int* in_sizes, int n_in, void* d_out, int out_size, void* d_ws, size_t ws_size, hipStream_t stream) {
    static int grid = 0;
    if (grid == 0) {
        if (n_in != N_IN || (size_t)out_size != O_END || ws_size < WS_END) { fprintf(stderr, "kernel_launch: unexpected problem shape (n_in %d out %d ws %zu)\n", n_in, out_size, ws_size); grid = -1; return; }
        int dev = 0, cus = 0;
        if (hipGetDevice(&dev) != hipSuccess || hipDeviceGetAttribute(&cus, hipDeviceAttributeMultiprocessorCount, dev) != hipSuccess) { grid = -1; return; }
        if (hipFuncSetAttribute((const void*)fwd_kernel, hipFuncAttributeMaxDynamicSharedMemorySize, LDS_BYTES) != hipSuccess) { fprintf(stderr, "kernel_launch: hipFuncSetAttribute failed\n"); grid = -1; return; }
        int per_cu = 0;
        if (hipOccupancyMaxActiveBlocksPerMultiprocessor(&per_cu, (const void*)fwd_kernel, NWAVES * 64, LDS_BYTES) != hipSuccess || per_cu < 1) { fprintf(stderr, "kernel_launch: occupancy query says %d\n", per_cu); }
        (void)hipGetLastError();
        grid = cus;
    }
    if (grid < 0) return;
    (void)hipMemsetAsync((char*)d_ws + WS_CTL, 0, CTL_ZERO_BYTES, stream);
    Args a{};
    for (int i = 0; i < N_IN; ++i) a.in[i] = (const float*)d_in[i];
    a.out = (float*)d_out; a.ws = (unsigned char*)d_ws;
    hipLaunchKernelGGL(fwd_kernel, dim3(grid), dim3(NWAVES * 64), LDS_BYTES, stream, a);
}
```
